# Optimizing an MI355X kernel written in HIP

```python
import math
import jax, jax.numpy as jnp
from jax import lax
import numpy as np

D_MODEL = 2048
BATCH = 16
SEQ = 256
DEPTH = 1
DEC_BATCH = 4
DEC_SEQ = 1024
PAST_LEN = 256

GRID_W = 64
H_A = 8
QK_A = 64
V_A = 2 * QK_A
H_B = 8
DK_B = 128
DV_B = 128
CONV_W = 3
CHUNK = 64
Q_BLOCK = 128
D_FF = 5632
ROPE_THETA = 10000.0
EPS = 1e-6
ATTN_Q = H_A * 2 * QK_A
ATTN_V = H_A * V_A
DN_QK = H_B * DK_B
DN_V = H_B * DV_B
DN_QKV = 2 * DN_QK + DN_V
MIX_W = ATTN_V + DN_V
N_IN = 2 * ATTN_Q + ATTN_V + DN_QKV + DN_V + 4 * H_B
SPLIT_IDX = [ATTN_Q, 2 * ATTN_Q, 2 * ATTN_Q + ATTN_V, 2 * ATTN_Q + ATTN_V + DN_QKV,
             2 * ATTN_Q + ATTN_V + DN_QKV + DN_V, 2 * ATTN_Q + ATTN_V + DN_QKV + DN_V + 2 * H_B]

kernel_name = "hymba_diffattn_gdn_prefix_dit"


def rmsnorm(x, g):
    xf = x.astype(jnp.float32)
    y = xf * lax.rsqrt(jnp.mean(xf * xf, axis=-1, keepdims=True) + EPS)
    return (y * g.astype(jnp.float32)).astype(x.dtype)


def l2norm(x):
    xf = x.astype(jnp.float32)
    return xf * lax.rsqrt(jnp.sum(xf * xf, axis=-1, keepdims=True) + EPS)


def modulation(cvec, w_mod, b_mod):
    m = jax.nn.silu(cvec) @ w_mod + b_mod
    return jnp.split(m[..., None, :], 6, axis=-1)


def dwconv_centred(x, w):
    k = w.shape[0]
    p = k // 2
    t = x.shape[1]
    xp = jnp.pad(x, ((0, 0), (p, p), (0, 0)))
    return sum(xp[:, i:i + t] * w[i] for i in range(k))


def axial_angles(t):
    rows = t // GRID_W
    r = jnp.repeat(jnp.arange(rows, dtype=jnp.float32), GRID_W)
    col = jnp.tile(jnp.arange(GRID_W, dtype=jnp.float32), rows)
    half = QK_A // 2
    inv = ROPE_THETA ** (-jnp.arange(0, half, 2, dtype=jnp.float32) / half)
    return r[:, None] * inv, col[:, None] * inv


def rotate_half_pairs(x, ang):
    x1, x2 = jnp.split(x, 2, axis=-1)
    cos, sin = jnp.cos(ang), jnp.sin(ang)
    return jnp.concatenate([x1 * cos - x2 * sin, x1 * sin + x2 * cos], axis=-1)


def apply_axial_rope(x, ang_r, ang_c):
    xf = x.astype(jnp.float32)
    xr, xc = jnp.split(xf, 2, axis=-1)
    bc = lambda a: a[None, :, None, None, :]
    return jnp.concatenate([rotate_half_pairs(xr, bc(ang_r)), rotate_half_pairs(xc, bc(ang_c))], axis=-1).astype(x.dtype)


def diff_attention(q1, q2, k1, k2, v, lam):
    b, t, h, d = q1.shape
    nb = t // Q_BLOCK
    scale = d ** -0.5
    k1f, k2f, vf = k1.astype(jnp.float32), k2.astype(jnp.float32), v.astype(jnp.float32)

    def block(qs):
        qa, qb = qs
        s1 = jnp.einsum('bqhd,bkhd->bhqk', qa.astype(jnp.float32), k1f) * scale
        s2 = jnp.einsum('bqhd,bkhd->bhqk', qb.astype(jnp.float32), k2f) * scale
        p = jax.nn.softmax(s1, axis=-1) - lam * jax.nn.softmax(s2, axis=-1)
        return jnp.einsum('bhqk,bkhd->bqhd', p, vf)

    split = lambda x: jnp.moveaxis(x.reshape(b, nb, Q_BLOCK, h, d), 1, 0)
    o = lax.map(block, (split(q1), split(q2)))
    return jnp.moveaxis(o, 0, 1).reshape(b, t, h, v.shape[-1])


def gated_delta_chunked(q, k, v, g, beta, s0):
    b, t, h, dk = q.shape
    dv = v.shape[-1]
    n = t // CHUNK

    def chunks(x):
        return jnp.moveaxis(x.reshape((b, n, CHUNK, h) + x.shape[3:]), 3, 1)

    q, k, v, g, beta = chunks(q), chunks(k), chunks(v), chunks(g), chunks(beta)
    gc = jnp.cumsum(g, axis=-1)
    incl = jnp.tril(jnp.ones((CHUNK, CHUNK), bool))
    strict = jnp.tril(jnp.ones((CHUNK, CHUNK), bool), -1)
    gamma = jnp.exp(jnp.where(incl, gc[..., :, None] - gc[..., None, :], -jnp.inf))
    kb = k * beta[..., None]
    a_mat = jnp.where(strict, jnp.einsum('bhncd,bhnsd->bhncs', kb, k) * gamma, 0.0)
    t_sys = a_mat + jnp.eye(CHUNK, dtype=jnp.float32)
    u = lax.linalg.triangular_solve(t_sys, v * beta[..., None], left_side=True, lower=True, unit_diagonal=True)
    w = lax.linalg.triangular_solve(t_sys, kb * jnp.exp(gc)[..., None], left_side=True, lower=True, unit_diagonal=True)
    qk = jnp.einsum('bhncd,bhnsd->bhncs', q, k) * gamma
    qg = q * jnp.exp(gc)[..., None]
    g_last = gc[..., -1]
    kd = k * jnp.exp(g_last[..., None] - gc)[..., None]
    dl = jnp.exp(g_last)

    def step(s, xs):
        u_n, w_n, qg_n, qk_n, kd_n, dl_n = xs
        v_new = u_n - jnp.einsum('bhcd,bhde->bhce', w_n, s)
        o_n = jnp.einsum('bhcd,bhde->bhce', qg_n, s) + jnp.einsum('bhcs,bhse->bhce', qk_n, v_new)
        s = s * dl_n[..., None, None] + jnp.einsum('bhcd,bhce->bhde', kd_n, v_new)
        return s, o_n

    xs = tuple(jnp.moveaxis(x, 2, 0) for x in (u, w, qg, qk, kd, dl))
    s_final, o = lax.scan(step, s0.astype(jnp.float32), xs)
    o = jnp.moveaxis(jnp.moveaxis(o, 0, 2), 1, 3).reshape(b, t, h, dv)
    return o, s_final


def bidir_delta(q, k, v, g, beta, s_f0, s_b0):
    flip = lambda x: jnp.flip(x, axis=1)
    o_f, s_f = gated_delta_chunked(q, k, v, g[:, :, 0], beta[:, :, 0], s_f0)
    o_b, s_b = gated_delta_chunked(flip(q), flip(k), flip(v), flip(g[:, :, 1]), flip(beta[:, :, 1]), s_b0)
    return o_f + flip(o_b), s_f, s_b


def mixer(h, w_in, conv_qkv_w, lam, lam_init, subln_g, a_log, dt_bias, dn_norm_g, w_out, ctx):
    b, t, _ = h.shape
    z = h @ w_in
    aq, ak, av, dqkv, dg, db, da = jnp.split(z, SPLIT_IDX, axis=-1)
    q = aq.reshape(b, t, H_A, 2, QK_A)
    k = ak.reshape(b, t, H_A, 2, QK_A)
    v = av.reshape(b, t, H_A, V_A)
    if ctx is None:
        keys, vals = k, v
        s_f0 = jnp.zeros((b, H_B, DK_B, DV_B), jnp.float32)
        s_b0 = s_f0
    else:
        ctx_k, ctx_v, s_f0, s_b0 = ctx
        ang_r, ang_c = axial_angles(t)
        q = apply_axial_rope(q, ang_r, ang_c)
        k = apply_axial_rope(k, ang_r, ang_c)
        keys = jnp.concatenate([k, ctx_k.reshape(b, ctx_k.shape[1], H_A, 2, QK_A).astype(k.dtype)], axis=1)
        vals = jnp.concatenate([v, ctx_v.astype(v.dtype)], axis=1)
    o_a = diff_attention(q[..., 0, :], q[..., 1, :], keys[..., 0, :], keys[..., 1, :], vals, lam)
    o_a = rmsnorm(o_a, subln_g) * (1.0 - lam_init)

    qkv = jax.nn.silu(dwconv_centred(dqkv, conv_qkv_w))
    dq, dk_, dv_ = jnp.split(qkv, [DN_QK, 2 * DN_QK], axis=-1)
    qd = l2norm(dq.reshape(b, t, H_B, DK_B)) * (DK_B ** -0.5)
    kd = l2norm(dk_.reshape(b, t, H_B, DK_B))
    vd = dv_.reshape(b, t, H_B, DV_B).astype(jnp.float32)
    beta = jax.nn.sigmoid(db.reshape(b, t, 2, H_B).astype(jnp.float32))
    gdec = -jnp.exp(a_log.astype(jnp.float32)) * jax.nn.softplus(
        da.reshape(b, t, 2, H_B).astype(jnp.float32) + dt_bias.astype(jnp.float32))
    o_d, s_f, s_b = bidir_delta(qd, kd, vd, gdec, beta, s_f0, s_b0)
    o_d = rmsnorm(o_d, dn_norm_g) * jax.nn.silu(dg.reshape(b, t, H_B, DV_B).astype(jnp.float32))

    o = jnp.concatenate([o_a.reshape(b, t, ATTN_V), o_d.reshape(b, t, DN_V)], axis=-1).astype(h.dtype)
    out = o @ w_out
    if ctx is None:
        return out, (ak.reshape(b, t, H_A, 2 * QK_A), v, s_f, s_b)
    return out, None


def conv_ffn(h, w_up, conv_w, w_down):
    u = dwconv_centred(h @ w_up, conv_w)
    gate, val = jnp.split(u, 2, axis=-1)
    return (jax.nn.silu(gate) * val) @ w_down


def trunk_layer(x, cvec, l, mod_w, mod_b, norm_mix_g, w_in, conv_qkv_w, lambda_q1, lambda_k1, lambda_q2,
                lambda_k2, subln_g, a_log, dt_bias, dn_norm_g, w_out, norm_ffn_g, w_up, conv_ffn_w, w_down, ctx):
    sh1, sc1, g1, sh2, sc2, g2 = modulation(cvec, mod_w[l], mod_b[l])
    lam_init = 0.8 - 0.6 * math.exp(-0.3 * l)
    lam = (jnp.exp(jnp.sum(lambda_q1[l].astype(jnp.float32) * lambda_k1[l].astype(jnp.float32)))
           - jnp.exp(jnp.sum(lambda_q2[l].astype(jnp.float32) * lambda_k2[l].astype(jnp.float32))) + lam_init)
    h = rmsnorm(x, norm_mix_g[l]) * (1 + sc1) + sh1
    m, new_ctx = mixer(h, w_in[l], conv_qkv_w[l], lam, lam_init, subln_g[l], a_log[l], dt_bias[l],
                       dn_norm_g[l], w_out[l], ctx)
    x = x + g1 * m
    h = rmsnorm(x, norm_ffn_g[l]) * (1 + sc2) + sh2
    x = x + g2 * conv_ffn(h, w_up[l], conv_ffn_w[l], w_down[l])
    return x, new_ctx


def setup_inputs(seed: int = 0) -> dict:
    key = jax.random.key(seed)
    ks = jax.random.split(key, 32)
    nrm = lambda i, shape, s=1.0: jax.random.normal(ks[i], shape, jnp.float32) * s
    centre = jnp.zeros((CONV_W, 1), jnp.float32).at[CONV_W // 2].set(1.0)
    dt = jnp.exp(jax.random.uniform(ks[26], (DEPTH, 2, H_B), jnp.float32, math.log(1e-3), math.log(1e-1)))
    return {
        "x_prompt": nrm(0, (BATCH, SEQ, D_MODEL)),
        "x_sample": nrm(1, (DEC_BATCH, DEC_SEQ, D_MODEL)),
        "cache_k": nrm(2, (DEC_BATCH, DEPTH, PAST_LEN, H_A, 2 * QK_A)),
        "cache_v": nrm(3, (DEC_BATCH, DEPTH, PAST_LEN, H_A, V_A)),
        "state_fwd": nrm(4, (DEC_BATCH, DEPTH, H_B, DK_B, DV_B), 0.1),
        "state_bwd": nrm(5, (DEC_BATCH, DEPTH, H_B, DK_B, DV_B), 0.1),
        "c": nrm(6, (DEC_BATCH, D_MODEL)),
        "c_ctx": nrm(7, (D_MODEL,)),
        "mod_w": nrm(8, (DEPTH, D_MODEL, 6 * D_MODEL), 0.5 * D_MODEL ** -0.5),
        "mod_b": nrm(9, (DEPTH, 6 * D_MODEL), 0.01),
        "norm_mix_g": 1.0 + nrm(10, (DEPTH, D_MODEL), 0.01),
        "w_in": nrm(11, (DEPTH, D_MODEL, N_IN), D_MODEL ** -0.5),
        "conv_qkv_w": centre + nrm(12, (DEPTH, CONV_W, DN_QKV), 0.2),
        "lambda_q1": nrm(13, (DEPTH, QK_A), 0.1),
        "lambda_k1": nrm(14, (DEPTH, QK_A), 0.1),
        "lambda_q2": nrm(15, (DEPTH, QK_A), 0.1),
        "lambda_k2": nrm(16, (DEPTH, QK_A), 0.1),
        "subln_g": 1.0 + nrm(17, (DEPTH, V_A), 0.01),
        "a_log": jnp.log(jax.random.uniform(ks[18], (DEPTH, 2, H_B), jnp.float32, 1.0, 16.0)),
        "dt_bias": dt + jnp.log(-jnp.expm1(-dt)),
        "dn_norm_g": 1.0 + nrm(19, (DEPTH, DV_B), 0.01),
        "w_out": nrm(20, (DEPTH, MIX_W, D_MODEL), MIX_W ** -0.5),
        "norm_ffn_g": 1.0 + nrm(21, (DEPTH, D_MODEL), 0.01),
        "w_up": nrm(22, (DEPTH, D_MODEL, 2 * D_FF), D_MODEL ** -0.5),
        "conv_ffn_w": centre + nrm(23, (DEPTH, CONV_W, 2 * D_FF), 0.2),
        "w_down": nrm(24, (DEPTH, D_FF, D_MODEL), D_FF ** -0.5),
        "final_g": 1.0 + nrm(25, (D_MODEL,), 0.01),
    }


def reference(x_prompt, x_sample, cache_k, cache_v, state_fwd, state_bwd, c, c_ctx, mod_w, mod_b, norm_mix_g,
              w_in, conv_qkv_w, lambda_q1, lambda_k1, lambda_q2, lambda_k2, subln_g, a_log, dt_bias, dn_norm_g,
              w_out, norm_ffn_g, w_up, conv_ffn_w, w_down, final_g):
    xp, xs = x_prompt, x_sample
    new_k, new_v, new_sf, new_sb = [], [], [], []
    for l in range(DEPTH):
        xp, (k_l, v_l, sf_l, sb_l) = trunk_layer(
            xp, c_ctx, l, mod_w, mod_b, norm_mix_g, w_in, conv_qkv_w, lambda_q1, lambda_k1, lambda_q2, lambda_k2,
            subln_g, a_log, dt_bias, dn_norm_g, w_out, norm_ffn_g, w_up, conv_ffn_w, w_down, None)
        new_k.append(k_l)
        new_v.append(v_l)
        new_sf.append(sf_l)
        new_sb.append(sb_l)
        xs, _ = trunk_layer(
            xs, c, l, mod_w, mod_b, norm_mix_g, w_in, conv_qkv_w, lambda_q1, lambda_k1, lambda_q2, lambda_k2,
            subln_g, a_log, dt_bias, dn_norm_g, w_out, norm_ffn_g, w_up, conv_ffn_w, w_down,
            (cache_k[:, l], cache_v[:, l], state_fwd[:, l], state_bwd[:, l]))
    y_prompt = rmsnorm(xp, final_g)
    y_sample = rmsnorm(xs, final_g)
    new_cache_k = jnp.stack(new_k, axis=1)
    new_cache_v = jnp.stack(new_v, axis=1)
    new_state_fwd = jnp.stack(new_sf, axis=1)
    new_state_bwd = jnp.stack(new_sb, axis=1)
    return (y_prompt, y_sample, new_cache_k, new_cache_v, new_state_fwd, new_state_bwd)
```

```cpp
#include <hip/hip_runtime.h>
#include <hip/hip_cooperative_groups.h>
#include <cstdio>
namespace cg = cooperative_groups;

typedef unsigned short u16;
typedef __attribute__((ext_vector_type(8))) short bf16x8;
typedef __attribute__((ext_vector_type(4))) short bf16x4;
typedef __attribute__((ext_vector_type(4))) float f32x4;
#define DI __device__ __forceinline__

constexpr int DM = 2048, NTOK = 8192, NPR = 4096;
constexpr int NIN = 7200, NINP = 7424, DFF = 5632, NUP = 11264;
constexpr int NTHR = 512;
constexpr int LDS_BYTES = 163776;
constexpr size_t OUT_CK = 16777216, OUT_CV = 20971520, OUT_SF = 25165824, OUT_SB = 27262976;
constexpr size_t OFF_WT_DOWN = 0;
constexpr size_t OFF_WT_IN = 23068672;
constexpr size_t OFF_WT_OUT = 53477376;
constexpr size_t OFF_WT_UP = 61865984;
constexpr size_t OFF_ABUF = 108003328;
constexpr size_t OFF_ACT = 141557760;
constexpr size_t OFF_UB = 141557760 + 92274688;
constexpr size_t OFF_X1B = 141557760 + 92274688 + 11534336;
constexpr size_t OFF_Z = 141557760;
constexpr size_t OFF_KBUF = 263192576;
constexpr size_t OFF_VT = 282066944;
constexpr size_t OFF_OF = 300941312;
constexpr size_t OFF_OB = 334495744;
constexpr size_t OFF_U = OFF_Z;
constexpr size_t OFF_GATES = 368050176;
constexpr size_t OFF_MODP = 369098752;
constexpr size_t OFF_MOD = 373030912;
constexpr size_t OFF_MISC = 373276672;
constexpr size_t OFF_BAR = OFF_MISC + 256;
constexpr size_t VT_SAMPLE = 4194304;

struct Params {
  const float *x_prompt, *x_sample, *cache_k, *cache_v, *state_fwd, *state_bwd, *c, *c_ctx, *mod_w, *mod_b,
      *norm_mix_g, *w_in, *conv_qkv_w, *lq1, *lk1, *lq2, *lk2, *subln_g, *a_log, *dt_bias, *dn_norm_g, *w_out,
      *norm_ffn_g, *w_up, *conv_ffn_w, *w_down, *final_g;
  float* out;
  char* ws;
  int phase_lo, phase_hi;
};

typedef __attribute__((ext_vector_type(4))) __bf16 hbf16x4;
DI u16 f2bf(float f) { return __builtin_bit_cast(u16, (__bf16)f); }
DI float bf2f(u16 h) { return __uint_as_float(((unsigned)h) << 16); }
DI float bf2f(short h) { return __uint_as_float(((unsigned)(u16)h) << 16); }
DI float silu_f(float x) { return x * __builtin_amdgcn_rcpf(1.f + __expf(-x)); }
DI int cvec_of(int tok) { return tok < NPR ? 4 : ((tok - NPR) >> 10); }
DI bf16x4 pack4(f32x4 v) { return __builtin_bit_cast(bf16x4, __builtin_convertvector(v, hbf16x4)); }

DI float4 ld4_bf(const u16* ptr) {
  const bf16x4 b = *(const bf16x4*)ptr;
  return make_float4(bf2f(b[0]), bf2f(b[1]), bf2f(b[2]), bf2f(b[3]));
}

DI void p0_gemv(const Params& p, int item, float* lds) {
  const int nch = item % 12, ks = item / 12, tid = threadIdx.x, lane = tid & 63;
  float sv[5][2];
#pragma unroll
  for (int v = 0; v < 5; ++v)
#pragma unroll
    for (int hh = 0; hh < 2; ++hh) {
      const int k = ks * 128 + hh * 64 + lane;
      sv[v][hh] = silu_f((v < 4) ? p.c[v * DM + k] : p.c_ctx[k]);
    }
  const int n = nch * 1024 + tid * 2;
  float a[5][2];
#pragma unroll
  for (int v = 0; v < 5; ++v) { a[v][0] = 0.f; a[v][1] = 0.f; }
  const float* w = p.mod_w + (size_t)(ks * 128) * 12288 + n;
#pragma unroll
  for (int hh = 0; hh < 2; ++hh) {
#pragma unroll 1
    for (int k0 = 0; k0 < 64; k0 += 16) {
      typedef __attribute__((ext_vector_type(2))) float f32x2_;
      f32x2_ wv[16];
#pragma unroll
      for (int kk = 0; kk < 16; ++kk) wv[kk] = __builtin_nontemporal_load((const f32x2_*)(w + (size_t)(hh * 64 + k0 + kk) * 12288));
#pragma unroll
      for (int kk = 0; kk < 16; ++kk)
#pragma unroll
        for (int v = 0; v < 5; ++v) {
          const float s = __shfl(sv[v][hh], k0 + kk);
          a[v][0] += s * wv[kk].x; a[v][1] += s * wv[kk].y;
        }
    }
  }
  float* modp = (float*)(p.ws + OFF_MODP);
#pragma unroll
  for (int v = 0; v < 5; ++v) {
    float b0 = 0.f, b1 = 0.f;
    if (ks == 0) { b0 = p.mod_b[n]; b1 = p.mod_b[n + 1]; }
    float2 o; o.x = a[v][0] + b0; o.y = a[v][1] + b1;
    *(float2*)(modp + (size_t)(ks * 5 + v) * 12288 + n) = o;
  }
}

struct TItem { const float* W; u16* Wt; int K, N, k0, n0, perm; };
DI TItem t_decode(const Params& p, int t) {
  TItem r;
  r.perm = 0;
  if (t < 464) { r.W = p.w_in; r.Wt = (u16*)(p.ws + OFF_WT_IN); r.K = DM; r.N = NIN; r.k0 = (t / 29) * 128; r.n0 = (t % 29) * 256; }
  else if (t < 592) { t -= 464; r.W = p.w_out; r.Wt = (u16*)(p.ws + OFF_WT_OUT); r.K = DM; r.N = DM; r.k0 = (t / 8) * 128; r.n0 = (t % 8) * 256; }
  else if (t < 1296) { t -= 592; r.W = p.w_up; r.Wt = (u16*)(p.ws + OFF_WT_UP); r.K = DM; r.N = NUP; r.k0 = (t / 44) * 128; r.n0 = (t % 44) * 256; r.perm = 1; }
  else { t -= 1296; r.W = p.w_down; r.Wt = (u16*)(p.ws + OFF_WT_DOWN); r.K = DFF; r.N = DM; r.k0 = (t / 8) * 128; r.n0 = (t % 8) * 256; }
  return r;
}
DI void t_load(const TItem& it, int tid, float4 (&v)[4][4]) {
#pragma unroll
  for (int sub = 0; sub < 4; ++sub)
#pragma unroll
    for (int i = 0; i < 4; ++i) {
      const int idx = tid + i * NTHR, kr = idx >> 4, c4 = idx & 15;
      int n = it.n0 + sub * 64 + c4 * 4;
      if (it.perm) n = (it.n0 >> 1) + (sub & 1) * 64 + c4 * 4 + (sub >> 1) * DFF;
      v[sub][i] = make_float4(0.f, 0.f, 0.f, 0.f);
      if (n < it.N) v[sub][i] = *(const float4*)(it.W + (size_t)(it.k0 + kr) * it.N + n);
    }
}
DI void t_store(const TItem& it, int tid, const float4 (&v)[4][4], u16* lds) {
#pragma unroll
  for (int sub = 0; sub < 4; ++sub)
#pragma unroll
    for (int i = 0; i < 4; ++i) {
      const int idx = tid + i * NTHR, kr = idx >> 4, c4 = idx & 15;
      u16* l = lds + (sub * 64 + c4 * 4) * 136 + (kr ^ ((c4 & 7) << 3));
      l[0] = f2bf(v[sub][i].x); l[136] = f2bf(v[sub][i].y); l[272] = f2bf(v[sub][i].z); l[408] = f2bf(v[sub][i].w);
    }
  __syncthreads();
#pragma unroll
  for (int sub = 0; sub < 4; ++sub) {
    const int n = sub * 64 + (tid >> 3), kc = tid & 7, sw = ((n >> 2) & 7) << 3;
    bf16x8 a = *(const bf16x8*)(lds + n * 136 + ((kc * 16) ^ sw));
    bf16x8 b2 = *(const bf16x8*)(lds + n * 136 + ((kc * 16 + 8) ^ sw));
    u16* dst = it.Wt + (size_t)(it.n0 + n) * it.K + it.k0 + kc * 16;
    *(bf16x8*)dst = a;
    *(bf16x8*)(dst + 8) = b2;
  }
}

DI void transposes_dyn(const Params& p, char* shm, int* ctr, int base, int soft_limit, int end, int max_items) {
  int tid_ = threadIdx.x;
  asm volatile("" : "+v"(tid_));
  const int tid = tid_;
  volatile int* s_next = (volatile int*)(shm + 131008);
  u16* lds = (u16*)shm;
  __syncthreads();
  if (tid == 0) *s_next = base + atomicAdd(ctr, 1);
  __syncthreads();
  int t = *s_next, taken = 1;
  float4 v[4][4];
  TItem cur = t_decode(p, t < end ? t : 0);
  if (t < end) t_load(cur, tid, v);
#pragma unroll 1
  while (t < end) {
    const bool more = (t < soft_limit) && (taken < max_items);
    __syncthreads();
    if (tid == 0) *s_next = more ? base + atomicAdd(ctr, 1) : end;
    __syncthreads();
    const int tn = *s_next;
    ++taken;
    float4 vn[4][4];
    TItem nxt = t_decode(p, tn < end ? tn : 0);
    if (tn < end) t_load(nxt, tid, vn);
    t_store(cur, tid, v, lds);
#pragma unroll
    for (int a_ = 0; a_ < 4; ++a_)
#pragma unroll
      for (int b_ = 0; b_ < 4; ++b_) v[a_][b_] = vn[a_][b_];
    cur = nxt; t = tn;
  }
  __syncthreads();
}

DI void phase0(const Params& p, char* shm) {
  const int tid = threadIdx.x;
  u16* kbuf = (u16*)(p.ws + OFF_KBUF);
  u16* vt = (u16*)(p.ws + OFF_VT);
  if (blockIdx.x < 192) p0_gemv(p, blockIdx.x, (float*)shm);
  for (int item = blockIdx.x; item < 768; item += gridDim.x) {
    if (item < 256) {
      int e = item * 4096 + tid * 8;
      int b = e >> 18, s = (e >> 10) & 255, cc = e & 1023;
      float4 v0 = *(const float4*)(p.cache_k + e), v1 = *(const float4*)(p.cache_k + e + 4);
      bf16x8 o;
      o[0] = (short)f2bf(v0.x); o[1] = (short)f2bf(v0.y); o[2] = (short)f2bf(v0.z); o[3] = (short)f2bf(v0.w);
      o[4] = (short)f2bf(v1.x); o[5] = (short)f2bf(v1.y); o[6] = (short)f2bf(v1.z); o[7] = (short)f2bf(v1.w);
      *(bf16x8*)(kbuf + (size_t)(NPR + b * 1280 + 1024 + s) * 1024 + cc) = o;
    } else {
      int idx = (item - 256) * NTHR + tid;
      int dv = idx & 127, h = (idx >> 7) & 7, s4 = (idx >> 10) & 63, b = idx >> 16;
      f32x4 v;
#pragma unroll
      for (int i = 0; i < 4; ++i) v[i] = p.cache_v[((size_t)(b * 256 + s4 * 4 + i) * 8 + h) * 128 + dv];
      *(bf16x4*)(vt + VT_SAMPLE + (size_t)((b * 8 + h) * 128 + dv) * 1280 + 1024 + s4 * 4) = pack4(v);
    }
  }
  transposes_dyn(p, shm, (int*)(p.ws + OFF_MISC + 64), 0, 592, 592, 1 << 30);
}

template <int MODE>
DI void norm_mod_phase(const Params& p, char* shm) {
  const int tid = threadIdx.x, lane = tid & 63, w = tid >> 6;
  float* sc = (float*)shm;
  float* sh = sc + DM;
  const float* modp = (const float*)(p.ws + OFF_MODP);
  float* mod = (float*)(p.ws + OFF_MOD);
  u16* dst = (u16*)(p.ws + OFF_ABUF);
  if (MODE == 0) {
    for (int i = blockIdx.x * NTHR + tid; i < 5 * 12288; i += gridDim.x * NTHR) {
      int v = i / 12288, n = i % 12288;
      float s = 0.f;
#pragma unroll
      for (int ks = 0; ks < 16; ++ks) s += modp[(size_t)(ks * 5 + v) * 12288 + n];
      mod[i] = s;
    }
  }
  for (int rb = blockIdx.x; rb < NTOK / 32; rb += gridDim.x) {
    const int row0 = rb * 32, cv = cvec_of(row0);
    __syncthreads();
    for (int k = tid; k < DM; k += NTHR) {
      float s_sh, s_sc, g;
      if (MODE == 0) {
        s_sh = 0.f; s_sc = 0.f;
#pragma unroll
        for (int ks = 0; ks < 16; ++ks) {
          s_sh += modp[(size_t)(ks * 5 + cv) * 12288 + k];
          s_sc += modp[(size_t)(ks * 5 + cv) * 12288 + 2048 + k];
        }
        g = p.norm_mix_g[k];
      } else {
        s_sh = mod[cv * 12288 + 6144 + k];
        s_sc = mod[cv * 12288 + 8192 + k];
        g = p.norm_ffn_g[k];
      }
      sc[k] = (1.f + s_sc) * g;
      sh[k] = s_sh;
    }
    __syncthreads();
#pragma unroll 1
    for (int i = 0; i < 4; ++i) {
      const int row = row0 + w * 4 + i;
      const float* src = (row < NPR) ? p.x_prompt + (size_t)row * DM : p.x_sample + (size_t)(row - NPR) * DM;
      const u16* srcb = (const u16*)(p.ws + OFF_X1B) + (size_t)row * DM;
      float4 v[8];
      float ss = 0.f;
#pragma unroll
      for (int ii = 0; ii < 8; ++ii) {
        if (MODE == 0) v[ii] = *(const float4*)(src + (ii * 64 + lane) * 4);
        else v[ii] = ld4_bf(srcb + (ii * 64 + lane) * 4);
        ss += v[ii].x * v[ii].x + v[ii].y * v[ii].y + v[ii].z * v[ii].z + v[ii].w * v[ii].w;
      }
#pragma unroll
      for (int o = 32; o > 0; o >>= 1) ss += __shfl_xor(ss, o);
      const float rs = rsqrtf(ss * (1.f / DM) + 1e-6f);
#pragma unroll
      for (int ii = 0; ii < 8; ++ii) {
        const int c = (ii * 64 + lane) * 4;
        f32x4 o;
        o[0] = v[ii].x * rs * sc[c] + sh[c];
        o[1] = v[ii].y * rs * sc[c + 1] + sh[c + 1];
        o[2] = v[ii].z * rs * sc[c + 2] + sh[c + 2];
        o[3] = v[ii].w * rs * sc[c + 3] + sh[c + 3];
        *(bf16x4*)(dst + (size_t)row * DM + c) = pack4(o);
      }
    }
  }
}

DI void final_norm_phase(const Params& p) {
  const int tid = threadIdx.x, lane = tid & 63, w = tid >> 6;
  for (int row = blockIdx.x * 8 + w; row < NTOK; row += gridDim.x * 8) {
    float* src = p.out + (size_t)row * DM;
    const u16* srcb = (const u16*)(p.ws + OFF_X1B) + (size_t)row * DM;
    float4 v[8];
    float ss = 0.f;
#pragma unroll
    for (int ii = 0; ii < 8; ++ii) {
      v[ii] = ld4_bf(srcb + (ii * 64 + lane) * 4);
      ss += v[ii].x * v[ii].x + v[ii].y * v[ii].y + v[ii].z * v[ii].z + v[ii].w * v[ii].w;
    }
#pragma unroll
    for (int o = 32; o > 0; o >>= 1) ss += __shfl_xor(ss, o);
    const float rs = rsqrtf(ss * (1.f / DM) + 1e-6f);
#pragma unroll
    for (int ii = 0; ii < 8; ++ii) {
      const int c = (ii * 64 + lane) * 4;
      float4 g = *(const float4*)(p.final_g + c);
      float4 o;
      o.x = v[ii].x * rs * g.x; o.y = v[ii].y * rs * g.y; o.z = v[ii].z * rs * g.z; o.w = v[ii].w * rs * g.w;
      { f32x4 ov = {o.x, o.y, o.z, o.w}; __builtin_nontemporal_store(ov, (f32x4*)(src + c)); }
    }
  }
}

#ifndef FILL_N
#define FILL_N 10
#endif
constexpr int BM = 256, BK = 64, HALF = 128, NXCD = 8, WGM = 8, HT = HALF * BK;

DI int lds_byte(int r, int c) {
  int st = (r >> 4) * 2 + (c >> 5), rr = r & 15, cc = c & 31, ob = rr * 64 + cc * 2;
  return st * 1024 + (ob ^ (((ob >> 9) & 1) << 5));
}
DI void stage_rc(int b, int& R, int& C) {
  int st = b / 1024, sb = b % 1024, swz = sb ^ (((sb >> 9) & 1) << 5);
  R = (st >> 1) * 16 + swz / 64; C = (st & 1) * 32 + (swz % 64) / 2;
}

template <int MODE>
DI void epi_read(const Params& p, const float* T, int rowbase, int bcol, int tid0) {
  int tid = tid0;
  asm volatile("" : "+v"(tid));
  const float* mod = (const float*)(p.ws + OFF_MOD);
  const int rsub = tid >> 5, cgp = tid & 31, c0 = (cgp >> 2) * 32 + (cgp & 3) * 4;
  const int gc0 = bcol + c0;
  if constexpr (MODE == 1) {
    const int pn = bcol >> 8;
    const bool sample = rowbase >= NPR;
    u16* Z = (u16*)(p.ws + OFF_Z);
    u16* kbuf = (u16*)(p.ws + OFF_KBUF);
    float* gates = (float*)(p.ws + OFF_GATES);
    const bool colpart = (cgp >> 2) & 1;
#pragma unroll 1
    for (int it = 0; it < 4; ++it) {
      const int lr = it * 16 + rsub;
      const int row = rowbase + (lr >> 5) * 64 + (lr & 31);
      f32x4 v0 = *(const f32x4*)(T + lr * 260 + c0), v1 = *(const f32x4*)(T + lr * 260 + c0 + 16);
      if (pn < 8) {
        if (!sample && pn >= 4) {
          __builtin_nontemporal_store(v0, (f32x4*)(p.out + OUT_CK + (size_t)row * 1024 + gc0 - 1024));
          __builtin_nontemporal_store(v1, (f32x4*)(p.out + OUT_CK + (size_t)row * 1024 + gc0 - 1024 + 16));
        }
        if (sample) {
          const int t = (row - NPR) & 1023;
          const float pos = (float)(colpart ? (t & 63) : (t >> 6));
#pragma unroll
          for (int e = 0; e < 4; ++e) {
            float sn, cs;
            __sincosf(pos * __builtin_amdgcn_exp2f(-(float)((cgp & 3) * 4 + e) * 0.830482024f), &sn, &cs);
            const float a = v0[e], b = v1[e];
            v0[e] = a * cs - b * sn;
            v1[e] = a * sn + b * cs;
          }
        }
        if (pn < 4) {
          *(bf16x4*)(Z + (size_t)row * NINP + gc0) = pack4(v0);
          *(bf16x4*)(Z + (size_t)row * NINP + gc0 + 16) = pack4(v1);
        } else {
          const int kr = sample ? (NPR + ((row - NPR) >> 10) * 1280 + ((row - NPR) & 1023)) : row;
          *(bf16x4*)(kbuf + (size_t)kr * 1024 + gc0 - 1024) = pack4(v0);
          *(bf16x4*)(kbuf + (size_t)kr * 1024 + gc0 - 1024 + 16) = pack4(v1);
        }
      } else if (pn < 12) {
        if (!sample) {
          __builtin_nontemporal_store(v0, (f32x4*)(p.out + OUT_CV + (size_t)row * 1024 + gc0 - 2048));
          __builtin_nontemporal_store(v1, (f32x4*)(p.out + OUT_CV + (size_t)row * 1024 + gc0 - 2048 + 16));
        }
      } else if (pn < 28) {
        *(bf16x4*)(Z + (size_t)row * NINP + gc0) = pack4(v0);
        *(bf16x4*)(Z + (size_t)row * NINP + gc0 + 16) = pack4(v1);
      } else {
        if (c0 < 16) {
          *(f32x4*)(gates + (size_t)row * 32 + c0) = v0;
          *(f32x4*)(gates + (size_t)row * 32 + c0 + 16) = v1;
        }
      }
    }
    if (pn >= 8 && pn < 12) {
      u16* vt = (u16*)(p.ws + OFF_VT);
      const int rgl = (tid >> 3) & 7, cl = (tid & 7) + 8 * (tid >> 6);
      const int ldk = sample ? 1280 : 256;
#pragma unroll 2
      for (int it = 0; it < 8; ++it) {
        const int lr = (rgl + 8 * (it & 1)) * 4;
        const int col = cl + 64 * (it >> 1);
        const int row = rowbase + (lr >> 5) * 64 + (lr & 31);
        size_t rowoff;
        if (!sample) rowoff = (size_t)((row >> 8) * 8) * 128 * 256 + (row & 255);
        else rowoff = VT_SAMPLE + (size_t)(((row - NPR) >> 10) * 8) * 128 * 1280 + ((row - NPR) & 1023);
        const int vc = bcol + col - 2048;
        f32x4 vv;
#pragma unroll
        for (int j = 0; j < 4; ++j) vv[j] = T[(lr + j) * 260 + col];
        *(bf16x4*)(vt + rowoff + (size_t)vc * ldk) = pack4(vv);
      }
    }
  } else if constexpr (MODE == 2 || MODE == 4) {
    const int cv = cvec_of(rowbase);
    const int goff = (MODE == 2) ? 4096 : 10240;
    const f32x4 g0 = *(const f32x4*)(mod + cv * 12288 + goff + gc0), g1 = *(const f32x4*)(mod + cv * 12288 + goff + gc0 + 16);
#pragma unroll
    for (int it = 0; it < 4; ++it) {
      const int lr = it * 16 + rsub;
      const int row = rowbase + (lr >> 5) * 64 + (lr & 31);
      const f32x4 v0 = *(const f32x4*)(T + lr * 260 + c0), v1 = *(const f32x4*)(T + lr * 260 + c0 + 16);
      u16* xb = (u16*)(p.ws + OFF_X1B) + (size_t)row * DM;
      f32x4 x0, x1;
      if (MODE == 2) {
        const float* xin = (row < NPR) ? p.x_prompt + (size_t)row * DM : p.x_sample + (size_t)(row - NPR) * DM;
        x0 = *(const f32x4*)(xin + gc0); x1 = *(const f32x4*)(xin + gc0 + 16);
      } else {
        const float4 a = ld4_bf(xb + gc0), b = ld4_bf(xb + gc0 + 16);
        x0 = f32x4{a.x, a.y, a.z, a.w}; x1 = f32x4{b.x, b.y, b.z, b.w};
      }
      *(bf16x4*)(xb + gc0) = pack4(x0 + g0 * v0);
      *(bf16x4*)(xb + gc0 + 16) = pack4(x1 + g1 * v1);
    }
  }
}

extern __shared__ __attribute__((aligned(16))) char g_shm[];

DI void gemm_epilogue_up(const Params& p, f32x4 (&acc)[2][2][4][2], int brow, int bcol, int wr, int wc, int fr, int fq, bool hm) {
  float* T = (float*)g_shm;
  u16* act = (u16*)(p.ws + OFF_ACT);
  u16* UB = (u16*)(p.ws + OFF_UB);
  int tid = threadIdx.x;
  asm volatile("" : "+v"(tid));
  const int pn = bcol >> 8;
  const int c4 = (tid & 31) * 4;
  float* WL = T + 64 * 260;
  if (tid < 192) {
    const int j = tid >> 6, q4 = (tid & 63) * 4;
    *(f32x4*)(WL + j * 256 + q4) = *(const f32x4*)(p.conv_ffn_w + j * NUP + (q4 < 128 ? pn * 128 + q4 : DFF + pn * 128 + q4 - 128));
  }
#pragma unroll
  for (int ps = 0; ps < 4; ++ps) {
    const int ai = ps >> 1, wsel = ps & 1;
    if (hm && ai == 1) continue;
    if (wr == wsel) {
      float* tp = T + (fq * 4) * 260 + wc * 32 + fr;
#pragma unroll
      for (int m = 0; m < 4; ++m)
#pragma unroll
        for (int bj = 0; bj < 2; ++bj)
#pragma unroll
          for (int n = 0; n < 2; ++n)
#pragma unroll
            for (int j = 0; j < 4; ++j) tp[(m * 16 + j) * 260 + bj * 128 + n * 16] = acc[ai][bj][m][n][j];
    }
    __syncthreads();
    const int rowbase = brow + ai * 128 + wsel * 64;
#pragma unroll 1
    for (int it = 0; it < 4; ++it) {
      const int lr = it * 16 + (tid >> 5);
      const int row = rowbase + lr;
      const f32x4 g0 = *(const f32x4*)(T + lr * 260 + c4), v0 = *(const f32x4*)(T + lr * 260 + 128 + c4);
      if (lr < 2 || lr >= 62) {
        const int slot = (row >> 6) * 4 + ((lr < 2) ? lr : lr - 60);
        *(bf16x4*)(UB + (size_t)slot * NUP + pn * 256 + c4) = pack4(g0);
        *(bf16x4*)(UB + (size_t)slot * NUP + pn * 256 + 128 + c4) = pack4(v0);
      }
      if (lr >= 1 && lr <= 62) {
        const f32x4 gm = *(const f32x4*)(T + (lr - 1) * 260 + c4), vm = *(const f32x4*)(T + (lr - 1) * 260 + 128 + c4);
        const f32x4 gp = *(const f32x4*)(T + (lr + 1) * 260 + c4), vp = *(const f32x4*)(T + (lr + 1) * 260 + 128 + c4);
        const f32x4 wg0 = *(const f32x4*)(WL + c4), wg1 = *(const f32x4*)(WL + 256 + c4), wg2 = *(const f32x4*)(WL + 512 + c4);
        const f32x4 wv0 = *(const f32x4*)(WL + 128 + c4), wv1 = *(const f32x4*)(WL + 384 + c4), wv2 = *(const f32x4*)(WL + 640 + c4);
        f32x4 o;
#pragma unroll
        for (int e = 0; e < 4; ++e) {
          const float gg = wg0[e] * gm[e] + wg1[e] * g0[e] + wg2[e] * gp[e];
          const float vv = wv0[e] * vm[e] + wv1[e] * v0[e] + wv2[e] * vp[e];
          o[e] = silu_f(gg) * vv;
        }
        *(bf16x4*)(act + (size_t)row * DFF + pn * 128 + c4) = pack4(o);
      }
    }
    __syncthreads();
  }
}

template <int MODE>
DI void gemm_epilogue(const Params& p, f32x4 (&acc)[2][2][4][2], int brow, int bcol, int wr, int wc, int fr, int fq, bool hm) {
  if constexpr (MODE == 3) { gemm_epilogue_up(p, acc, brow, bcol, wr, wc, fr, fq, hm); return; }
  float* T = (float*)g_shm;
#pragma unroll
  for (int ps = 0; ps < 4; ++ps) {
    const int ai = ps >> 1, mh = ps & 1;
    {
      float* tp = T + (wr * 32 + fq * 4) * 260 + wc * 32 + fr;
#pragma unroll
      for (int mm = 0; mm < 2; ++mm)
#pragma unroll
        for (int bj = 0; bj < 2; ++bj)
#pragma unroll
          for (int n = 0; n < 2; ++n)
#pragma unroll
            for (int j = 0; j < 4; ++j) tp[(mm * 16 + j) * 260 + bj * 128 + n * 16] = acc[ai][bj][mh * 2 + mm][n][j];
    }
    __syncthreads();
    epi_read<MODE>(p, T, brow + ai * 128 + mh * 32, bcol, (int)threadIdx.x);
    __syncthreads();
  }
}

template <int MODE>
DI void gemm_phase(const Params& p, const u16* __restrict__ A, const u16* __restrict__ Bt, int M, int N, int K) {
  u16* shm = (u16*)g_shm;
  int tix = threadIdx.x;
  asm volatile("" : "+v"(tix));
#define SA(b, h) (shm + ((b) * 2 + (h)) * HT)
#define SB(b, h) (shm + (4 + (b) * 2 + (h)) * HT)
#define STAGE(P, BASE, br, kt)                                                                      \
  do {                                                                                              \
    const char* _gb = (const char*)((BASE) + (long)(br) * K + (long)(kt) * BK);                     \
    __builtin_amdgcn_global_load_lds((const unsigned*)(_gb + voff0),                                \
        (__attribute__((address_space(3))) unsigned*)((char*)(P) + tix * 16), 16, 0, 0);    \
    __builtin_amdgcn_global_load_lds((const unsigned*)(_gb + voff1),                                \
        (__attribute__((address_space(3))) unsigned*)((char*)(P) + tix * 16 + 8192), 16, 0, 0); \
  } while (0)
#define LDA(dst, b, h) for (int m = 0; m < 4; ++m) for (int k = 0; k < 2; ++k) \
    dst[m][k] = *reinterpret_cast<const bf16x8*>((char*)SA(b, h) + lds_byte(wr * 64 + m * 16 + fr, k * 32 + fq * 8))
#define LDB(dst, b, h) for (int n = 0; n < 2; ++n) for (int k = 0; k < 2; ++k) \
    dst[n][k] = *reinterpret_cast<const bf16x8*>((char*)SB(b, h) + lds_byte(wc * 32 + n * 16 + fr, k * 32 + fq * 8))
#define MMA(ai, bj, At, Bt_)                                                                        \
  do {                                                                                              \
    __builtin_amdgcn_s_setprio(1);                                                                  \
    for (int m = 0; m < 4; ++m) for (int n = 0; n < 2; ++n) for (int k = 0; k < 2; ++k)             \
      acc[ai][bj][m][n] = __builtin_amdgcn_mfma_f32_16x16x32_bf16(At[m][k], Bt_[n][k], acc[ai][bj][m][n], 0, 0, 0); \
    __builtin_amdgcn_s_setprio(0);                                                                  \
  } while (0)
#define WAIT_V(n) asm volatile("s_waitcnt vmcnt(" #n ")" ::: "memory")
#define WAIT_L(n) asm volatile("s_waitcnt lgkmcnt(" #n ")" ::: "memory")
#define BAR __builtin_amdgcn_s_barrier()
#define SCHED __builtin_amdgcn_sched_barrier(0)

  const int nM = M / BM, nN = N / BM, nwg = nM * nN;
  const int wid = __builtin_amdgcn_readfirstlane(tix >> 6), lane = tix & 63, wr = wid >> 2, wc = wid & 3, fr = lane & 15, fq = lane >> 4;
  const int nt = K / BK;
  unsigned voff0, voff1;
  { int _r, _c; stage_rc(tix * 16, _r, _c); voff0 = (unsigned)(_r * K + _c) * 2u;
    stage_rc(tix * 16 + 8192, _r, _c); voff1 = (unsigned)(_r * K + _c) * 2u; }
  const int G_ = (int)gridDim.x, rem_ = nwg % G_;
  const bool split = (MODE == 3) && rem_ > 0 && rem_ * 2 <= G_;
  const int nfull = split ? nwg - rem_ : nwg, nunits = nfull + (split ? 2 * rem_ : 0);
#pragma unroll 1
  for (int unit = blockIdx.x; unit < nunits; unit += gridDim.x) {
    asm volatile("" : "+v"(voff0), "+v"(voff1));
    const bool hm = unit >= nfull;
    const int tile = hm ? nfull + ((unit - nfull) >> 1) : unit, hsel = hm ? ((unit - nfull) & 1) : 0;
    int wgid = tile;
    { int q = nwg / NXCD, r = nwg % NXCD, xcd = wgid % NXCD, off = wgid / NXCD;
      wgid = (xcd < r ? xcd * (q + 1) : r * (q + 1) + (xcd - r) * q) + off; }
    const int nig = WGM * nN, gid = wgid / nig, fm = gid * WGM, gsz = min(nM - fm, WGM);
    const int pm = fm + ((wgid % nig) % gsz), pn = (wgid % nig) / gsz, brow = pm * BM + hsel * HALF, bcol = pn * BM;
    const int brow2 = hm ? brow : brow + HALF;
    f32x4 acc[2][2][4][2] = {};
    bf16x8 At[4][2], B0[2][2], B1[2][2];
    STAGE(SB(0, 0), Bt, bcol, 0); STAGE(SA(0, 0), A, brow, 0);
    STAGE(SB(0, 1), Bt, bcol + HALF, 0); STAGE(SA(0, 1), A, brow2, 0);
    if (wr == 1) BAR;
    WAIT_V(4); BAR;
    STAGE(SB(1, 0), Bt, bcol, 1); STAGE(SA(1, 0), A, brow, 1); STAGE(SB(1, 1), Bt, bcol + HALF, 1);
    WAIT_V(6); BAR;
#pragma unroll 1
    for (int t = 0; t < nt - 2; t += 2) {
      LDB(B0, 0, 0); SCHED; LDA(At, 0, 0); STAGE(SA(1, 1), A, brow2, t + 1);
      WAIT_L(8); BAR; WAIT_L(0); MMA(0, 0, At, B0); BAR; SCHED;
      LDB(B1, 0, 1); STAGE(SB(0, 0), Bt, bcol, t + 2);
      BAR; WAIT_L(0); MMA(0, 1, At, B1); BAR;
      if (!hm) { LDA(At, 0, 1); } STAGE(SA(0, 0), A, brow, t + 2);
      BAR; WAIT_L(0); if (!hm) MMA(1, 0, At, B0); BAR; SCHED;
      STAGE(SB(0, 1), Bt, bcol + HALF, t + 2);
      WAIT_V(6); BAR; if (!hm) MMA(1, 1, At, B1); BAR;
      LDB(B0, 1, 0); SCHED; LDA(At, 1, 0); STAGE(SA(0, 1), A, brow2, t + 2);
      WAIT_L(8); BAR; WAIT_L(0); MMA(0, 0, At, B0); BAR; SCHED;
      LDB(B1, 1, 1); STAGE(SB(1, 0), Bt, bcol, t + 3);
      BAR; WAIT_L(0); MMA(0, 1, At, B1); BAR;
      if (!hm) { LDA(At, 1, 1); } STAGE(SA(1, 0), A, brow, t + 3);
      BAR; WAIT_L(0); if (!hm) MMA(1, 0, At, B0); BAR; SCHED;
      STAGE(SB(1, 1), Bt, bcol + HALF, t + 3);
      WAIT_V(6); BAR; if (!hm) MMA(1, 1, At, B1); BAR;
    }
    { LDB(B0, 0, 0); LDA(At, 0, 0); STAGE(SA(1, 1), A, brow2, nt - 1);
      BAR; WAIT_L(0); MMA(0, 0, At, B0); BAR;
      LDB(B1, 0, 1); BAR; WAIT_L(0); MMA(0, 1, At, B1); BAR;
      if (!hm) { LDA(At, 0, 1); } WAIT_V(4); BAR; WAIT_L(0); if (!hm) { MMA(1, 0, At, B0); MMA(1, 1, At, B1); } BAR; }
    { LDB(B0, 1, 0); LDA(At, 1, 0); WAIT_V(2); BAR; WAIT_L(0); MMA(0, 0, At, B0); BAR;
      LDB(B1, 1, 1); WAIT_V(0); BAR; WAIT_L(0); MMA(0, 1, At, B1); BAR;
      if (!hm) { LDA(At, 1, 1); } BAR; WAIT_L(0); if (!hm) { MMA(1, 0, At, B0); MMA(1, 1, At, B1); } BAR; }
    if (wr == 0) BAR;
    gemm_epilogue<MODE>(p, acc, brow, bcol, wr, wc, fr, fq, hm);
  }
  if constexpr (MODE == 1 || MODE == 3) {
    const int rounds = (nunits + (int)gridDim.x - 1) / (int)gridDim.x;
    const int mine = (nunits - (int)blockIdx.x + (int)gridDim.x - 1) / (int)gridDim.x;
    if (mine < rounds) transposes_dyn(p, g_shm, (int*)(p.ws + OFF_MISC + 128), 592, 1648, 1648, FILL_N);
  }
#undef SA
#undef SB
}

#define MFMA16(a, b, c) __builtin_amdgcn_mfma_f32_16x16x32_bf16((a), (b), (c), 0, 0, 0)

DI void attn_item(const Params& p, int a, char* shm, float lam) {
  int tid_ = threadIdx.x;
  asm volatile("" : "+v"(tid_));
  const int tid = tid_, lane = tid & 63, w = __builtin_amdgcn_readfirstlane(tid >> 6), fr = lane & 15, fq = lane >> 4;
  const u16* Z = (const u16*)(p.ws + OFF_Z);
  const u16* kbuf = (const u16*)(p.ws + OFF_KBUF);
  const u16* vtg = (const u16*)(p.ws + OFF_VT);
  u16* obuf = (u16*)(p.ws + OFF_ABUF);
  int b, h, qtok0, krow0, nk, LK;
  const u16* vt;
  if (a < 256) {
    b = a >> 6; h = (a >> 3) & 7; const int qb = a & 7;
    qtok0 = NPR + b * 1024 + qb * 128; krow0 = NPR + b * 1280; nk = 1280; LK = 1280;
    vt = vtg + VT_SAMPLE + (size_t)((b * 8 + h) * 128) * 1280;
  } else {
    const int a2 = a - 256;
    b = a2 >> 4; h = (a2 >> 1) & 7; const int qb = a2 & 1;
    qtok0 = b * 256 + qb * 128; krow0 = b * 256; nk = 256; LK = 256;
    vt = vtg + (size_t)((b * 8 + h) * 128) * 256;
  }
  u16* Kl = (u16*)shm;
  u16* Vl = (u16*)(shm + 17408);
  bf16x8 qf[2][2];
  {
    const u16* qp = Z + (size_t)(qtok0 + w * 16 + fr) * NINP + h * 128 + fq * 8;
#pragma unroll
    for (int mp = 0; mp < 2; ++mp)
#pragma unroll
      for (int ks = 0; ks < 2; ++ks) qf[mp][ks] = *(const bf16x8*)(qp + mp * 64 + ks * 32);
  }
  f32x4 O[2][8];
#pragma unroll
  for (int mp = 0; mp < 2; ++mp)
#pragma unroll
    for (int dt = 0; dt < 8; ++dt) O[mp][dt] = f32x4{0.f, 0.f, 0.f, 0.f};
  float mx[2] = {-1e30f, -1e30f}, ls[2] = {0.f, 0.f};
  const float SC = 0.125f * 1.44269504089f;
  const u16* kg = kbuf + (size_t)(krow0 + (tid >> 4)) * 1024 + h * 128 + (tid & 15) * 8;
  const u16* vg = vt + (size_t)(tid >> 3) * LK + (tid & 7) * 8;
  bf16x8 kr0 = *(const bf16x8*)(kg), kr1 = *(const bf16x8*)(kg + 32 * 1024);
  bf16x8 vr0 = *(const bf16x8*)(vg), vr1 = *(const bf16x8*)(vg + (size_t)64 * LK);
  const int ntile = nk >> 6;
  __syncthreads();
  *(bf16x8*)(Kl + (tid >> 4) * 136 + (tid & 15) * 8) = kr0;
  *(bf16x8*)(Kl + ((tid >> 4) + 32) * 136 + (tid & 15) * 8) = kr1;
  *(bf16x8*)(Vl + (tid >> 3) * 72 + (tid & 7) * 8) = vr0;
  *(bf16x8*)(Vl + ((tid >> 3) + 64) * 72 + (tid & 7) * 8) = vr1;
  __syncthreads();
#pragma unroll 1
  for (int kt = 0; kt < ntile; ++kt) {
    Kl = (u16*)(shm + (kt & 1) * 35840);
    Vl = (u16*)(shm + (kt & 1) * 35840 + 17408);
    if (kt + 1 < ntile) {
      kr0 = *(const bf16x8*)(kg + (size_t)(kt + 1) * 64 * 1024);
      kr1 = *(const bf16x8*)(kg + (size_t)(kt + 1) * 64 * 1024 + 32 * 1024);
      vr0 = *(const bf16x8*)(vg + (kt + 1) * 64);
      vr1 = *(const bf16x8*)(vg + (size_t)64 * LK + (kt + 1) * 64);
    }
    bf16x8 pb[2][2];
#pragma unroll
    for (int mp = 0; mp < 2; ++mp) {
      f32x4 s[4];
#pragma unroll
      for (int t16 = 0; t16 < 4; ++t16) {
        s[t16] = f32x4{0.f, 0.f, 0.f, 0.f};
#pragma unroll
        for (int ks = 0; ks < 2; ++ks) {
          bf16x8 ka = *(const bf16x8*)(Kl + (t16 * 16 + fr) * 136 + mp * 64 + ks * 32 + fq * 8);
          s[t16] = MFMA16(ka, qf[mp][ks], s[t16]);
        }
      }
      float tm = -1e30f;
#pragma unroll
      for (int t16 = 0; t16 < 4; ++t16)
#pragma unroll
        for (int j = 0; j < 4; ++j) tm = fmaxf(tm, s[t16][j]);
      tm *= SC;
      tm = fmaxf(tm, __shfl_xor(tm, 16));
      tm = fmaxf(tm, __shfl_xor(tm, 32));
      const float mnew = fmaxf(mx[mp], tm);
      const float alpha = __builtin_amdgcn_exp2f(mx[mp] - mnew);
      mx[mp] = mnew;
      float lsum = 0.f;
#pragma unroll
      for (int t16 = 0; t16 < 4; ++t16)
#pragma unroll
        for (int j = 0; j < 4; ++j) {
          const float pv = __builtin_amdgcn_exp2f(s[t16][j] * SC - mnew);
          s[t16][j] = pv;
          lsum += pv;
        }
      ls[mp] = ls[mp] * alpha + lsum;
#pragma unroll
      for (int dt = 0; dt < 8; ++dt) {
        O[mp][dt][0] *= alpha; O[mp][dt][1] *= alpha; O[mp][dt][2] *= alpha; O[mp][dt][3] *= alpha;
      }
#pragma unroll
      for (int hf = 0; hf < 2; ++hf) {
        bf16x4 lo = pack4(s[2 * hf]), hi = pack4(s[2 * hf + 1]);
        pb[mp][hf] = bf16x8{lo[0], lo[1], lo[2], lo[3], hi[0], hi[1], hi[2], hi[3]};
      }
    }
#pragma unroll
    for (int hf = 0; hf < 2; ++hf)
#pragma unroll
      for (int dt = 0; dt < 8; ++dt) {
        bf16x4 va = *(const bf16x4*)(Vl + (dt * 16 + fr) * 72 + hf * 32 + fq * 4);
        bf16x4 vb = *(const bf16x4*)(Vl + (dt * 16 + fr) * 72 + hf * 32 + 16 + fq * 4);
        bf16x8 av = bf16x8{va[0], va[1], va[2], va[3], vb[0], vb[1], vb[2], vb[3]};
        O[0][dt] = MFMA16(av, pb[0][hf], O[0][dt]);
        O[1][dt] = MFMA16(av, pb[1][hf], O[1][dt]);
      }
    if (kt + 1 < ntile) {
      u16* Kn = (u16*)(shm + ((kt + 1) & 1) * 35840);
      u16* Vn = (u16*)(shm + ((kt + 1) & 1) * 35840 + 17408);
      *(bf16x8*)(Kn + (tid >> 4) * 136 + (tid & 15) * 8) = kr0;
      *(bf16x8*)(Kn + ((tid >> 4) + 32) * 136 + (tid & 15) * 8) = kr1;
      *(bf16x8*)(Vn + (tid >> 3) * 72 + (tid & 7) * 8) = vr0;
      *(bf16x8*)(Vn + ((tid >> 3) + 64) * 72 + (tid & 7) * 8) = vr1;
    }
    __syncthreads();
  }
  float l0 = ls[0], l1 = ls[1];
  l0 += __shfl_xor(l0, 16); l0 += __shfl_xor(l0, 32);
  l1 += __shfl_xor(l1, 16); l1 += __shfl_xor(l1, 32);
  const float i0 = 1.f / l0, i1 = lam / l1;
  float ss = 0.f;
#pragma unroll
  for (int dt = 0; dt < 8; ++dt)
#pragma unroll
    for (int j = 0; j < 4; ++j) {
      const float o = O[0][dt][j] * i0 - O[1][dt][j] * i1;
      O[0][dt][j] = o;
      ss += o * o;
    }
  ss += __shfl_xor(ss, 16); ss += __shfl_xor(ss, 32);
  const float rs = rsqrtf(ss * (1.f / 128.f) + 1e-6f) * 0.8f;
  u16* op = obuf + (size_t)(qtok0 + w * 16 + fr) * DM + h * 128 + fq * 4;
#pragma unroll
  for (int dt = 0; dt < 8; ++dt) {
    float4 g = *(const float4*)(p.subln_g + dt * 16 + fq * 4);
    f32x4 o;
    o[0] = O[0][dt][0] * rs * g.x; o[1] = O[0][dt][1] * rs * g.y; o[2] = O[0][dt][2] * rs * g.z; o[3] = O[0][dt][3] * rs * g.w;
    *(bf16x4*)(op + dt * 16) = pack4(o);
  }
}

DI void ld16(const u16* ptr, bool valid, float (&x)[16]) {
  bf16x8 a = {0, 0, 0, 0, 0, 0, 0, 0}, b = {0, 0, 0, 0, 0, 0, 0, 0};
  if (valid) { a = *(const bf16x8*)ptr; b = *(const bf16x8*)(ptr + 8); }
#pragma unroll
  for (int e = 0; e < 8; ++e) { x[e] = bf2f(a[e]); x[8 + e] = bf2f(b[e]); }
}
template <int PART>
DI void conv16(const u16* zr, bool hasm, bool hasp, const float* cw, int pp, float (&y)[16]) {
  float xm[16], x0[16], xp[16];
  ld16(zr + PART * 1024 - NINP, hasm, xm);
  ld16(zr + PART * 1024, true, x0);
  ld16(zr + PART * 1024 + NINP, hasp, xp);
#pragma unroll
  for (int c = 0; c < 16; ++c) {
    const int cc = PART * 128 + pp * 16 + c;
    y[c] = silu_f(cw[cc] * xm[c] + cw[384 + cc] * x0[c] + cw[768 + cc] * xp[c]);
  }
}
DI bf16x8 cat44(bf16x4 a, bf16x4 b) { return bf16x8{a[0], a[1], a[2], a[3], b[0], b[1], b[2], b[3]}; }

constexpr size_t OFF_VC = OFF_WT_IN;
DI void dn_prep_phase(const Params& p, char* shm) {
  int tid_ = threadIdx.x;
  asm volatile("" : "+v"(tid_));
  const int tid = tid_;
  u16* Z = (u16*)(p.ws + OFF_Z);
  u16* VC = (u16*)(p.ws + OFF_VC);
  float* gates = (float*)(p.ws + OFF_GATES);
  float* cw = (float*)shm;
  __syncthreads();
  for (int i = tid; i < 9216; i += NTHR) cw[i] = p.conv_qkv_w[i];
  __syncthreads();
  {
    const int lane = tid & 63, wv = __builtin_amdgcn_readfirstlane(tid >> 6);
#pragma unroll 1
    for (int task = blockIdx.x * 8 + wv; task < 2048; task += gridDim.x * 8) {
      const int chunk = task >> 4, j = task & 15, dirj = j >> 3;
      const size_t tk = (size_t)chunk * 64 + (dirj ? 63 - lane : lane);
      const float bb = gates[tk * 32 + j];
      const float aa = gates[tk * 32 + 16 + j] + p.dt_bias[j];
      const float sp = aa > 20.f ? aa : log1pf(__expf(aa));
      float g = -__expf(p.a_log[j]) * sp;
#pragma unroll
      for (int o = 1; o < 64; o <<= 1) {
        float t = __shfl_up(g, o);
        if (lane >= o) g += t;
      }
      gates[tk * 32 + j] = 1.f / (1.f + __expf(-bb));
      gates[tk * 32 + 16 + j] = g;
    }
  }
  const int tl = tid >> 6, h = (tid >> 3) & 7, pp = tid & 7;
#pragma unroll 1
  for (int it = blockIdx.x; it < NTOK / 8; it += gridDim.x) {
    const int tok = it * 8 + tl;
    const int tn = tok < NPR ? (tok & 255) : ((tok - NPR) & 1023);
    const int T = tok < NPR ? 256 : 1024;
    const bool hasm = tn > 0, hasp = tn < T - 1;
    const u16* zr = Z + (size_t)tok * NINP + 3072 + h * 128 + pp * 16;
    bf16x8 t0, t1;
#pragma unroll
    for (int part = 0; part < 3; ++part) {
      float xm[16], x0[16], xp[16], y[16];
      ld16(zr + part * 1024 - NINP, hasm, xm);
      ld16(zr + part * 1024, true, x0);
      ld16(zr + part * 1024 + NINP, hasp, xp);
      const float* w0 = cw + part * 1024 + h * 128 + pp * 16;
      float ss = 0.f;
#pragma unroll
      for (int c = 0; c < 16; ++c) {
        y[c] = silu_f(w0[c] * xm[c] + w0[3072 + c] * x0[c] + w0[6144 + c] * xp[c]);
        ss += y[c] * y[c];
      }
      float sc = 1.f;
      if (part < 2) {
#pragma unroll
        for (int o = 1; o < 8; o <<= 1) ss += __shfl_xor(ss, o);
        sc = rsqrtf(ss + 1e-6f) * (part == 0 ? 0.08838834764831845f : 1.f);
      }
#pragma unroll
      for (int c = 0; c < 8; ++c) { t0[c] = (short)f2bf(y[c] * sc); t1[c] = (short)f2bf(y[8 + c] * sc); }
      u16* dst = (part == 0) ? Z + (size_t)tok * NINP + 1024 + h * 128 + pp * 16
               : (part == 1) ? Z + (size_t)tok * NINP + 2048 + h * 128 + pp * 16
                             : VC + (size_t)tok * 1024 + h * 128 + pp * 16;
      *(bf16x8*)dst = t0;
      *(bf16x8*)(dst + 8) = t1;
    }
  }
}

#ifndef DNSEL
#define DNSEL 31
#endif
DI void dn_item(const Params& p, int seq, int h, int dir, char* shm) {
  int tid_ = threadIdx.x;
  asm volatile("" : "+v"(tid_));
  const int tid = tid_, lane = tid & 63, w = __builtin_amdgcn_readfirstlane(tid >> 6), fr = lane & 15, fq = lane >> 4;
  const int tid0 = tid, fr0 = fr, fq0 = fq;
#define LANE_VARS int tid = tid0, fr = fr0, fq = fq0; asm volatile("" : "+v"(tid), "+v"(fr), "+v"(fq));
  const bool sample = seq >= 16;
  const int T = sample ? 1024 : 256;
  const int tokbase = sample ? NPR + (seq - 16) * 1024 : seq * 256;
  const int nch = T >> 6;
  const u16* Z = (const u16*)(p.ws + OFF_Z);
  const float* gates = (const float*)(p.ws + OFF_GATES);
  float* obuf = (float*)(p.ws + (dir ? OFF_OB : OFF_OF));
  u16* qs = (u16*)(shm);
  u16* ksl = (u16*)(shm + 17408);
  u16* kdT = (u16*)(shm + 34816);
  u16* R = (u16*)(shm + 53248);
  float* Ad = (float*)(shm + 87040);
  u16* Abf = (u16*)(shm + 91136);
  u16* TinvL = (u16*)(shm + 100352);
  u16* qkm = (u16*)(shm + 102912);
  float* cw = (float*)(shm + 112128);
  float* gcs = (float*)(shm + 116736);
  float* betas = (float*)(shm + 116992);
  float* graw = (float*)(shm + 117248);
  u16* qs2 = (u16*)(shm + 117760);
  u16* kdT2 = (u16*)(shm + 135168);
  float* gcs2 = (float*)(shm + 153600);
  float* betas2 = (float*)(shm + 153856);
  __syncthreads();
  const u16* VC = (const u16*)(p.ws + OFF_VC);
  bf16x8 cq0, cq1, ck0, ck1, cv0, cv1;
  float pb_ = 0.f, pg = 0.f, pgl = 0.f;
  {
    const int ip = tid >> 3, pp = tid & 7;
    const int cn0 = dir ? nch - 1 : 0;
    const size_t tok0 = (size_t)tokbase + cn0 * 64 + (dir ? 63 - ip : ip);
    const u16* zq = Z + tok0 * NINP + 1024 + h * 128 + pp * 16;
    cq0 = *(const bf16x8*)zq; cq1 = *(const bf16x8*)(zq + 8);
    ck0 = *(const bf16x8*)(zq + 1024); ck1 = *(const bf16x8*)(zq + 1032);
    const u16* vq = VC + tok0 * 1024 + h * 128 + pp * 16;
    cv0 = *(const bf16x8*)vq; cv1 = *(const bf16x8*)(vq + 8);
    pb_ = gates[tok0 * 32 + dir * 8 + h]; pg = gates[tok0 * 32 + 16 + dir * 8 + h];
    pgl = gates[((size_t)tokbase + cn0 * 64 + (dir ? 0 : 63)) * 32 + 16 + dir * 8 + h];
  }
  f32x4 S[8];
  if (sample) {
    const float* s0 = (dir ? p.state_bwd : p.state_fwd) + (size_t)((seq - 16) * 8 + h) * 16384;
#pragma unroll
    for (int dt = 0; dt < 8; ++dt)
#pragma unroll
      for (int j = 0; j < 4; ++j) S[dt][j] = s0[(dt * 16 + fq * 4 + j) * 128 + w * 16 + fr];
  } else {
#pragma unroll
    for (int dt = 0; dt < 8; ++dt) S[dt] = f32x4{0.f, 0.f, 0.f, 0.f};
  }

#define DN_A1(QSN, KDN, GCN, BTN)                                                                   \
  do {                                                                                              \
    const int ip = tid >> 3, pp = tid & 7;                                                          \
    const float gci = pg, glast = pgl;                                                              \
    if (pp == 0) { (GCN)[ip] = gci; (BTN)[ip] = pb_; }                                              \
    const float ekd = __expf(glast - gci);                                                          \
    *(bf16x8*)((QSN) + ip * 136 + pp * 16) = cq0; *(bf16x8*)((QSN) + ip * 136 + pp * 16 + 8) = cq1; \
    *(bf16x8*)(ksl + ip * 136 + pp * 16) = ck0; *(bf16x8*)(ksl + ip * 136 + pp * 16 + 8) = ck1;      \
    _Pragma("unroll") for (int c = 0; c < 8; ++c) {                                                 \
      (KDN)[(pp * 16 + c) * 72 + (ip ^ (pp << 3))] = f2bf(bf2f(ck0[c]) * ekd);                      \
      (KDN)[(pp * 16 + 8 + c) * 72 + (ip ^ (pp << 3))] = f2bf(bf2f(ck1[c]) * ekd);                  \
    }                                                                                               \
  } while (0)
#define DN_A2(NEXT_OK, CN2)                                                                         \
  do {                                                                                              \
    const int ip = tid >> 3, pp = tid & 7;                                                          \
    const float beta = pb_, bk = pb_ * __expf(pg);                                                  \
    bf16x8 t0, t1;                                                                                  \
    _Pragma("unroll") for (int c = 0; c < 8; ++c) { t0[c] = (short)f2bf(bf2f(ck0[c]) * bk); t1[c] = (short)f2bf(bf2f(ck1[c]) * bk); } \
    *(bf16x8*)(R + ip * 264 + 128 + pp * 16) = t0; *(bf16x8*)(R + ip * 264 + 128 + pp * 16 + 8) = t1; \
    _Pragma("unroll") for (int c = 0; c < 8; ++c) { t0[c] = (short)f2bf(bf2f(cv0[c]) * beta); t1[c] = (short)f2bf(bf2f(cv1[c]) * beta); } \
    *(bf16x8*)(R + ip * 264 + pp * 16) = t0; *(bf16x8*)(R + ip * 264 + pp * 16 + 8) = t1;          \
    if (NEXT_OK) {                                                                                  \
      const int cn2 = (CN2);                                                                        \
      const size_t tok2 = (size_t)tokbase + cn2 * 64 + (dir ? 63 - ip : ip);                        \
      const u16* zq = Z + tok2 * NINP + 1024 + h * 128 + pp * 16;                                   \
      cq0 = *(const bf16x8*)zq; cq1 = *(const bf16x8*)(zq + 8);                                     \
      ck0 = *(const bf16x8*)(zq + 1024); ck1 = *(const bf16x8*)(zq + 1032);                         \
      const u16* vq = VC + tok2 * 1024 + h * 128 + pp * 16;                                         \
      cv0 = *(const bf16x8*)vq; cv1 = *(const bf16x8*)(vq + 8);                                     \
      pb_ = gates[tok2 * 32 + dir * 8 + h]; pg = gates[tok2 * 32 + 16 + dir * 8 + h];               \
      pgl = gates[((size_t)tokbase + cn2 * 64 + (dir ? 0 : 63)) * 32 + 16 + dir * 8 + h];           \
    }                                                                                               \
  } while (0)
  const bf16x4 z4 = {0, 0, 0, 0};
  {
    LANE_VARS
    DN_A1(qs, kdT, gcs, betas);
    DN_A2(true, (dir ? nch - 2 : 1));
  }
  __syncthreads();
#pragma unroll 1
  for (int s = 0; s < nch; ++s) {
    const int cn = dir ? nch - 1 - s : s;
    u16* qsc = (s & 1) ? qs2 : qs;   u16* qsn = (s & 1) ? qs : qs2;
    u16* kdc = (s & 1) ? kdT2 : kdT; u16* kdn = (s & 1) ? kdT : kdT2;
    float* gcc = (s & 1) ? gcs2 : gcs;     float* gcn = (s & 1) ? gcs : gcs2;
    float* btc = (s & 1) ? betas2 : betas; float* btn = (s & 1) ? betas : betas2;
    if (s > 0) {
      LANE_VARS
      DN_A2(s + 1 < nch, (dir ? nch - 2 - s : s + 1));
    }
    if (DNSEL & 2) {
      LANE_VARS
      const int ti = w >> 1;
#pragma unroll
      for (int tjj = 0; tjj < 2; ++tjj) {
        const int tj = (w & 1) * 2 + tjj;
        f32x4 akk = f32x4{0.f, 0.f, 0.f, 0.f}, aqk = f32x4{0.f, 0.f, 0.f, 0.f};
#pragma unroll
        for (int ks = 0; ks < 4; ++ks) {
          bf16x8 ak = *(const bf16x8*)(ksl + (ti * 16 + fr) * 136 + ks * 32 + fq * 8);
          bf16x8 aq = *(const bf16x8*)(qsc + (ti * 16 + fr) * 136 + ks * 32 + fq * 8);
          bf16x8 bk = *(const bf16x8*)(ksl + (tj * 16 + fr) * 136 + ks * 32 + fq * 8);
          akk = MFMA16(ak, bk, akk);
          aqk = MFMA16(aq, bk, aqk);
        }
        const int jj = tj * 16 + fr;
        const float gj = gcc[jj];
#pragma unroll
        for (int j = 0; j < 4; ++j) {
          const int i = ti * 16 + fq * 4 + j;
          const float e = (i >= jj) ? __expf(gcc[i] - gj) : 0.f;
          const float av = (i > jj) ? btc[i] * akk[j] * e : 0.f;
          Abf[i * 72 + jj] = f2bf(-av);
          if (ti == tj) Ad[(ti * 16 + fq * 4 + j) * 16 + fr] = av;
          qkm[i * 72 + jj] = f2bf(aqk[j] * e);
        }
        if (ti == tj) {
          asm volatile("s_waitcnt lgkmcnt(0)" ::: "memory");
          __builtin_amdgcn_wave_barrier();
          if (lane < 16) {
            const float* ab = Ad + ti * 256;
            f32x4 av[16][4];
#pragma unroll
            for (int i = 1; i < 16; ++i)
#pragma unroll
              for (int q = 0; q < (i + 3) / 4; ++q) av[i][q] = *(const f32x4*)(ab + i * 16 + q * 4);
            float x[16];
#pragma unroll
            for (int i = 0; i < 16; ++i) {
              float a = (i == lane) ? 1.f : 0.f;
#pragma unroll
              for (int j = 0; j < i; ++j) a -= av[i][j >> 2][j & 3] * x[j];
              x[i] = a;
              TinvL[(ti * 16 + i) * 20 + lane] = f2bf(a);
            }
          }
        }
      }
    }
    __syncthreads();
    if (DNSEL & 8) {
      LANE_VARS
      bf16x4 a10, a20, a21, a30, a31, a32, ti[4];
      {
        const u16* ar = Abf + fr * 72 + fq * 4;
        a10 = *(const bf16x4*)(ar + 16 * 72);
        a20 = *(const bf16x4*)(ar + 32 * 72); a21 = *(const bf16x4*)(ar + 32 * 72 + 16);
        a30 = *(const bf16x4*)(ar + 48 * 72); a31 = *(const bf16x4*)(ar + 48 * 72 + 16); a32 = *(const bf16x4*)(ar + 48 * 72 + 32);
#pragma unroll
        for (int t = 0; t < 4; ++t) ti[t] = *(const bf16x4*)(TinvL + (t * 16 + fr) * 20 + fq * 4);
      }
      f32x4 rhs[2][4];
#pragma unroll
      for (int cti = 0; cti < 2; ++cti)
#pragma unroll
        for (int t = 0; t < 4; ++t)
#pragma unroll
          for (int j = 0; j < 4; ++j) rhs[cti][t][j] = bf2f(R[(t * 16 + fq * 4 + j) * 264 + (w * 2 + cti) * 16 + fr]);
      __builtin_amdgcn_sched_barrier(0);
      f32x4 Y[2][4];
      const f32x4 zf = f32x4{0.f, 0.f, 0.f, 0.f};
#pragma unroll
      for (int t = 0; t < 4; ++t) {
#pragma unroll
        for (int cti = 0; cti < 2; ++cti) {
          f32x4 acc = rhs[cti][t];
          if (t == 1) {
            acc = MFMA16(cat44(a10, z4), cat44(pack4(Y[cti][0]), z4), acc);
          } else if (t == 2) {
            acc = MFMA16(cat44(a20, a21), cat44(pack4(Y[cti][0]), pack4(Y[cti][1])), acc);
          } else if (t == 3) {
            acc = MFMA16(cat44(a30, a31), cat44(pack4(Y[cti][0]), pack4(Y[cti][1])), acc);
            acc = MFMA16(cat44(a32, z4), cat44(pack4(Y[cti][2]), z4), acc);
          }
          Y[cti][t] = MFMA16(cat44(ti[t], z4), cat44(pack4(acc), z4), zf);
        }
      }
#pragma unroll
      for (int cti = 0; cti < 2; ++cti)
#pragma unroll
        for (int t = 0; t < 4; ++t)
#pragma unroll
          for (int j = 0; j < 4; ++j) R[(t * 16 + fq * 4 + j) * 264 + (w * 2 + cti) * 16 + fr] = f2bf(Y[cti][t][j]);
    }
    __syncthreads();
    if (DNSEL & 16) {
      LANE_VARS
      bf16x8 Bs[4];
#pragma unroll
      for (int kk = 0; kk < 4; ++kk) Bs[kk] = cat44(pack4(S[2 * kk]), pack4(S[2 * kk + 1]));
      f32x4 vnew[4], qS[4];
#pragma unroll
      for (int tt = 0; tt < 4; ++tt) {
        f32x4 aw = f32x4{0.f, 0.f, 0.f, 0.f}, aq = f32x4{0.f, 0.f, 0.f, 0.f};
#pragma unroll
        for (int kk = 0; kk < 4; ++kk) {
          const u16* wp = R + (tt * 16 + fr) * 264 + 128 + kk * 32 + fq * 4;
          const u16* qp = qsc + (tt * 16 + fr) * 136 + kk * 32 + fq * 4;
          bf16x8 Aw = cat44(*(const bf16x4*)wp, *(const bf16x4*)(wp + 16));
          bf16x8 Aq = cat44(*(const bf16x4*)qp, *(const bf16x4*)(qp + 16));
          aw = MFMA16(Aw, Bs[kk], aw);
          aq = MFMA16(Aq, Bs[kk], aq);
        }
#pragma unroll
        for (int j = 0; j < 4; ++j) vnew[tt][j] = bf2f(R[(tt * 16 + fq * 4 + j) * 264 + w * 16 + fr]) - aw[j];
        qS[tt] = aq;
      }
      bf16x8 Bv[2];
      Bv[0] = cat44(pack4(vnew[0]), pack4(vnew[1]));
      Bv[1] = cat44(pack4(vnew[2]), pack4(vnew[3]));
      const float dl = __expf(gcc[63]);
#pragma unroll
      for (int tt = 0; tt < 4; ++tt) {
        f32x4 o2 = f32x4{0.f, 0.f, 0.f, 0.f};
#pragma unroll
        for (int k2 = 0; k2 < 2; ++k2) {
          const u16* ap = qkm + (tt * 16 + fr) * 72 + k2 * 32 + fq * 4;
          bf16x8 Aqk = cat44(*(const bf16x4*)ap, *(const bf16x4*)(ap + 16));
          o2 = MFMA16(Aqk, Bv[k2], o2);
        }
#pragma unroll
        for (int j = 0; j < 4; ++j) {
          const int ip = tt * 16 + fq * 4 + j;
          const int inat = dir ? 63 - ip : ip;
          const float o = __expf(gcc[ip]) * qS[tt][j] + o2[j];
          obuf[((size_t)tokbase + cn * 64 + inat) * 1024 + h * 128 + w * 16 + fr] = o;
        }
      }
#pragma unroll
      for (int dt = 0; dt < 8; ++dt) {
        f32x4 sn;
        sn[0] = S[dt][0] * dl; sn[1] = S[dt][1] * dl; sn[2] = S[dt][2] * dl; sn[3] = S[dt][3] * dl;
#pragma unroll
        for (int k2 = 0; k2 < 2; ++k2) {
          const u16* ap = kdc + (dt * 16 + fr) * 72;
          bf16x8 Ak = cat44(*(const bf16x4*)(ap + ((k2 * 32 + fq * 4) ^ (dt << 3))), *(const bf16x4*)(ap + ((k2 * 32 + 16 + fq * 4) ^ (dt << 3))));
          sn = MFMA16(Ak, Bv[k2], sn);
        }
        S[dt] = sn;
      }
      if (s + 1 < nch) DN_A1(qsn, kdn, gcn, btn);
    }
    __syncthreads();
  }
  if (!sample) {
    float* so = p.out + (dir ? OUT_SB : OUT_SF) + (size_t)(seq * 8 + h) * 16384;
#pragma unroll
    for (int dt = 0; dt < 8; ++dt)
#pragma unroll
      for (int j = 0; j < 4; ++j) so[(dt * 16 + fq * 4 + j) * 128 + w * 16 + fr] = S[dt][j];
  }
}

#undef DN_A1
#undef DN_A2
DI void phase3(const Params& p, char* shm) {
  const int lane = threadIdx.x & 63;
  float a = p.lq1[lane] * p.lk1[lane], b = p.lq2[lane] * p.lk2[lane];
#pragma unroll
  for (int o = 32; o > 0; o >>= 1) { a += __shfl_xor(a, o); b += __shfl_xor(b, o); }
  const float lam = __expf(a) - __expf(b) + 0.2f;
  bool did_long = false;
  int* ctr = (int*)(p.ws + OFF_MISC);
  volatile int* s_item = (volatile int*)(shm + 163712);
#pragma unroll 1
  for (;;) {
    __syncthreads();
    if (threadIdx.x == 0) *s_item = atomicAdd(ctr, 1);
    __syncthreads();
    const int item = *s_item;
    if (item >= 832) break;
    int isdn, arg;
    if (item < 64) { isdn = 1; arg = ((16 + (item >> 4)) << 4) | (item & 15); }
    else if (item < 320) { isdn = 0; arg = item - 64; }
    else if (item < 576) { isdn = 1; arg = item - 320; }
    else { isdn = 0; arg = item - 576 + 256; }
    if (isdn) dn_item(p, arg >> 4, (arg >> 1) & 7, arg & 1, shm);
    else attn_item(p, arg, shm, lam);
    if (item < 64) did_long = true;
    __syncthreads();
  }
  if (!did_long) transposes_dyn(p, shm, (int*)(p.ws + OFF_MISC + 128), 592, 1648, 1648, 2);
}

DI void phase4(const Params& p) {
  const int tid = threadIdx.x, lane = tid & 63, w = tid >> 6;
  const float* of = (const float*)(p.ws + OFF_OF);
  const float* ob = (const float*)(p.ws + OFF_OB);
  const u16* Z = (const u16*)(p.ws + OFF_Z);
  u16* obuf = (u16*)(p.ws + OFF_ABUF);
  const int dv4 = (lane & 31) * 4;
  const float4 g = *(const float4*)(p.dn_norm_g + dv4);
  for (int it = blockIdx.x; it < 4096; it += gridDim.x) {
    const int pi = it * 16 + w * 2 + (lane >> 5);
    const int tok = pi >> 3, h = pi & 7;
    const size_t off = (size_t)tok * 1024 + h * 128 + dv4;
    float4 a = *(const float4*)(of + off), b = *(const float4*)(ob + off);
    a.x += b.x; a.y += b.y; a.z += b.z; a.w += b.w;
    float ss = a.x * a.x + a.y * a.y + a.z * a.z + a.w * a.w;
#pragma unroll
    for (int o = 1; o < 32; o <<= 1) ss += __shfl_xor(ss, o);
    const float rs = rsqrtf(ss * (1.f / 128.f) + 1e-6f);
    bf16x4 dg = *(const bf16x4*)(Z + (size_t)tok * NINP + 6144 + h * 128 + dv4);
    f32x4 o;
    o[0] = a.x * rs * g.x * silu_f(bf2f(dg[0]));
    o[1] = a.y * rs * g.y * silu_f(bf2f(dg[1]));
    o[2] = a.z * rs * g.z * silu_f(bf2f(dg[2]));
    o[3] = a.w * rs * g.w * silu_f(bf2f(dg[3]));
    *(bf16x4*)(obuf + (size_t)tok * DM + 1024 + h * 128 + dv4) = pack4(o);
  }
}

DI void phase8(const Params& p) {
  const u16* UB = (const u16*)(p.ws + OFF_UB);
  u16* act = (u16*)(p.ws + OFF_ACT);
  const bf16x8 zero8 = {0, 0, 0, 0, 0, 0, 0, 0};
#pragma unroll 1
  for (int task = blockIdx.x * NTHR + threadIdx.x; task < 256 * 704; task += gridDim.x * NTHR) {
    const int ridx = task / 704, ch = (task % 704) * 8;
    const int blk = ridx >> 1, last = ridx & 1;
    const int r = blk * 64 + (last ? 63 : 0);
    const int pn = ch >> 7, c = ch & 127;
    const int s0 = blk * 4 + (last ? 3 : 0);
    const int sm = last ? blk * 4 + 2 : (blk - 1) * 4 + 3;
    const int sp = last ? (blk + 1) * 4 + 0 : blk * 4 + 1;
    const bool okm = last ? true : ((r < NPR) ? ((r & 255) != 0) : (((r - NPR) & 1023) != 0));
    const bool okp = last ? (((r + 1) < NPR) ? (((r + 1) & 255) != 0) : ((((r + 1) - NPR) & 1023) != 0)) : true;
    const size_t co = (size_t)pn * 256 + c;
    bf16x8 gm = zero8, vm = zero8, gp = zero8, vp = zero8;
    const bf16x8 g0 = *(const bf16x8*)(UB + (size_t)s0 * NUP + co), v0 = *(const bf16x8*)(UB + (size_t)s0 * NUP + co + 128);
    if (okm) { gm = *(const bf16x8*)(UB + (size_t)sm * NUP + co); vm = *(const bf16x8*)(UB + (size_t)sm * NUP + co + 128); }
    if (okp) { gp = *(const bf16x8*)(UB + (size_t)sp * NUP + co); vp = *(const bf16x8*)(UB + (size_t)sp * NUP + co + 128); }
    bf16x8 o;
#pragma unroll
    for (int e = 0; e < 8; ++e) {
      const float gg = p.conv_ffn_w[ch + e] * bf2f(gm[e]) + p.conv_ffn_w[NUP + ch + e] * bf2f(g0[e]) + p.conv_ffn_w[2 * NUP + ch + e] * bf2f(gp[e]);
      const float vv = p.conv_ffn_w[DFF + ch + e] * bf2f(vm[e]) + p.conv_ffn_w[NUP + DFF + ch + e] * bf2f(v0[e]) +
                       p.conv_ffn_w[2 * NUP + DFF + ch + e] * bf2f(vp[e]);
      o[e] = (short)f2bf(silu_f(gg) * vv);
    }
    *(bf16x8*)(act + (size_t)r * DFF + ch) = o;
  }
}

#define XB_TMO      128
#define XB_XCNT(j)  (256  + 64 * (j))
#define XB_XSUB(j)  (1280 + 64 * (j))
#define XB_XGEN(j)  (2304 + 64 * (j))
#define XB_TOP      3328
#define XB_TOPGEN   3392
#define XCD_BAR_WORDS 3456
#define XB_SPIN_CAP (1u << 18)
#define LAS __attribute__((address_space(3)))
DI unsigned xb_ld(unsigned* p) { return __hip_atomic_load(p, __ATOMIC_RELAXED, __HIP_MEMORY_SCOPE_AGENT); }
DI unsigned xb_add(unsigned* p, unsigned v) { return __hip_atomic_fetch_add(p, v, __ATOMIC_RELAXED, __HIP_MEMORY_SCOPE_AGENT); }
DI unsigned xb_xcc_id() { return (unsigned)__builtin_amdgcn_s_getreg((3 << 11) | 20) & 0xFu; }
#define XB_SPIN(cond, bar) do { unsigned _sp = 0; while (cond) { __builtin_amdgcn_s_sleep(1); \
    if ((++_sp & 255u) == 0u) { if (xb_ld(&(bar)[XB_TMO])) break; if (_sp > XB_SPIN_CAP) { atomicAdd(&(bar)[XB_TMO], 1u); break; } } } } while (0)
struct XcdBarrier { unsigned* bar; unsigned x; volatile LAS unsigned* st; };
DI XcdBarrier xcd_barrier_post(unsigned* bar, volatile LAS unsigned* st) {
  XcdBarrier b; b.bar = bar; b.x = xb_xcc_id(); b.st = st;
  if (threadIdx.x == 0) (void)xb_add(&bar[XB_XCNT(b.x)], 1u);
  return b;
}
DI void xcd_barrier_complete(unsigned* bar, unsigned x, unsigned& nloc, unsigned& nx) {
  const unsigned G = gridDim.x * gridDim.y * gridDim.z;
  unsigned sum, cnt, mine, sp = 0u;
  for (;;) {
    sum = 0u; cnt = 0u; mine = 0u;
#pragma unroll
    for (unsigned j = 0; j < 16; ++j) { const unsigned c = xb_ld(&bar[XB_XCNT(j)]); sum += c; cnt += (c > 0u) ? 1u : 0u; mine = (j == x) ? c : mine; }
    if (sum == G) break;
    __builtin_amdgcn_s_sleep(1);
    if ((++sp & 255u) == 0u) { if (xb_ld(&bar[XB_TMO])) break; if (sp > XB_SPIN_CAP) { atomicAdd(&bar[XB_TMO], 1u); break; } }
  }
  nloc = mine > 0u ? mine : 1u; nx = cnt > 0u ? cnt : 1u;
}
DI void xcd_barrier(const XcdBarrier& b) {
  asm volatile("s_waitcnt vmcnt(0)" ::: "memory");
  __syncthreads();
  if (threadIdx.x == 0) {
    unsigned* bar = b.bar;
    __builtin_amdgcn_s_waitcnt(0);
    unsigned nloc = b.st[0], nx = b.st[1];
    if (nloc == 0u) { xcd_barrier_complete(bar, b.x, nloc, nx); b.st[0] = nloc; b.st[1] = nx; }
    const unsigned old = xb_add(&bar[XB_XSUB(b.x)], 1u);
    const unsigned gen = old / nloc;
    if (old + 1u == (gen + 1u) * nloc) {
      __builtin_amdgcn_fence(__ATOMIC_RELEASE, "agent");
      asm volatile("s_waitcnt vmcnt(0)" ::: "memory");
      const unsigned og = xb_add(&bar[XB_TOP], 1u);
      const unsigned tg = og / nx;
      if (og + 1u == (tg + 1u) * nx) xb_add(&bar[XB_TOPGEN], 1u);
      else XB_SPIN(xb_ld(&bar[XB_TOPGEN]) == tg, bar);
      __builtin_amdgcn_fence(__ATOMIC_ACQUIRE, "agent");
      xb_add(&bar[XB_XGEN(b.x)], 1u);
      asm volatile("s_waitcnt vmcnt(0)" ::: "memory");
    } else {
      XB_SPIN(xb_ld(&bar[XB_XGEN(b.x)]) == gen, bar);
      __builtin_amdgcn_fence(__ATOMIC_ACQUIRE, "agent");
      asm volatile("s_waitcnt vmcnt(0)" ::: "memory");
    }
  }
  __syncthreads();
}

__global__ void __launch_bounds__(NTHR) mega(Params p) {
  cg::grid_group grid = cg::this_grid();
  char* shm = g_shm;
  __shared__ uint4 xb_words;
  if (threadIdx.x == 0) xb_words = make_uint4(0u, 0u, 0u, 0u);
  __syncthreads();
  XcdBarrier xb = xcd_barrier_post((unsigned*)(p.ws + OFF_BAR), (volatile LAS unsigned*)&xb_words);
  if (p.phase_hi > 1000) grid.sync();
#ifndef ONLY
#define ONLY -1
#endif
#ifndef DOUBLE_PHASE
#define DOUBLE_PHASE -1
#endif
#define RUN(ph, call)                                                   \
  if (p.phase_lo <= (ph) && (ph) < p.phase_hi) {                        \
    if ((ph) > p.phase_lo) xcd_barrier(xb);                             \
    if (ONLY < 0 || ONLY == (ph)) { call; }                             \
    if (DOUBLE_PHASE == (ph)) { xcd_barrier(xb); if (blockIdx.x == 0 && threadIdx.x == 0) *(int*)(p.ws + OFF_MISC) = 0; xcd_barrier(xb); call; } \
  }
  RUN(0, phase0(p, shm))
  RUN(1, norm_mod_phase<0>(p, shm))
  RUN(2, gemm_phase<1>(p, (const u16*)(p.ws + OFF_ABUF), (const u16*)(p.ws + OFF_WT_IN), NTOK, NINP, DM))
  RUN(11, dn_prep_phase(p, shm))
  RUN(3, phase3(p, shm))
  RUN(4, phase4(p))
  RUN(5, gemm_phase<2>(p, (const u16*)(p.ws + OFF_ABUF), (const u16*)(p.ws + OFF_WT_OUT), NTOK, DM, DM))
  RUN(6, (norm_mod_phase<1>(p, shm), transposes_dyn(p, shm, (int*)(p.ws + OFF_MISC + 128), 592, 1296, 1648, 1 << 30)))
  RUN(7, gemm_phase<3>(p, (const u16*)(p.ws + OFF_ABUF), (const u16*)(p.ws + OFF_WT_UP), NTOK, NUP, DM))
  RUN(8, (phase8(p), transposes_dyn(p, shm, (int*)(p.ws + OFF_MISC + 128), 592, 1648, 1648, 1 << 30)))
  RUN(9, gemm_phase<4>(p, (const u16*)(p.ws + OFF_ACT), (const u16*)(p.ws + OFF_WT_DOWN), NTOK, DM, DFF))
  RUN(10, final_norm_phase(p))
}

#ifndef N_LAUNCH_SPLIT
#define N_LAUNCH_SPLIT 0
#endif

extern "C" void kernel_launch(void* const* d_in, const int* in_sizes, int n_in, void* d_out, int out_size, void* d_ws,
                              size_t ws_size, hipStream_t stream) {
  static int grid_blocks = 0;
  if (!grid_blocks) {
    int dev = 0, cus = 0, per_cu = 0;
    hipGetDevice(&dev);
    hipDeviceGetAttribute(&cus, hipDeviceAttributeMultiprocessorCount, dev);
    hipFuncSetAttribute((const void*)mega, hipFuncAttributeMaxDynamicSharedMemorySize, LDS_BYTES);
    hipOccupancyMaxActiveBlocksPerMultiprocessor(&per_cu, mega, NTHR, LDS_BYTES);
    if (per_cu < 1) per_cu = 1;
    grid_blocks = cus * per_cu;
    if (grid_blocks > 256) grid_blocks = 256;
  }
  Params p{};
  const float** f = (const float**)&p;
  for (int i = 0; i < 27; ++i) f[i] = (const float*)d_in[i];
  p.out = (float*)d_out;
  p.ws = (char*)d_ws;
#if N_LAUNCH_SPLIT
  for (int ph = 0; ph < 11; ++ph) {
    p.phase_lo = ph; p.phase_hi = ph + 1;
    hipLaunchKernelGGL(mega, dim3(grid_blocks), dim3(NTHR), LDS_BYTES, stream, p);
  }
#else
  p.phase_lo = 0; p.phase_hi = 12;
  hipMemsetAsync((char*)d_ws + OFF_MISC, 0, 256 + 3456 * 4, stream);
  void* args[] = {&p};
  hipError_t e = hipLaunchCooperativeKernel((void*)mega, dim3(grid_blocks), dim3(NTHR), args, LDS_BYTES, stream);
  if (e != hipSuccess) fprintf(stderr, "cooperative launch failed: %s (grid %d)\n", hipGetErrorString(e), grid_blocks);
#endif
}
```

```cpp
#include <hip/hip_runtime.h>
#include <hip/hip_cooperative_groups.h>
#include <cstdio>
namespace cg = cooperative_groups;

typedef unsigned short u16;
typedef __attribute__((ext_vector_type(8))) short bf16x8;
typedef __attribute__((ext_vector_type(4))) short bf16x4;
typedef __attribute__((ext_vector_type(4))) float f32x4;
#define DI __device__ __forceinline__

constexpr int DM = 2048, NTOK = 8192, NPR = 4096;
constexpr int NIN = 7200, NINP = 7424, DFF = 5632, NUP = 11264;
constexpr int NTHR = 512;
constexpr int LDS_BYTES = 163776;
constexpr size_t OUT_CK = 16777216, OUT_CV = 20971520, OUT_SF = 25165824, OUT_SB = 27262976;
constexpr size_t OFF_WT_DOWN = 0;
constexpr size_t OFF_WT_IN = 23068672;
constexpr size_t OFF_WT_OUT = 53477376;
constexpr size_t OFF_WT_UP = 61865984;
constexpr size_t OFF_ABUF = 108003328;
constexpr size_t OFF_ACT = 141557760;
constexpr size_t OFF_UB = 141557760 + 92274688;
constexpr size_t OFF_X1B = 141557760 + 92274688 + 11534336;
constexpr size_t OFF_Z = 141557760;
constexpr size_t OFF_KBUF = 263192576;
constexpr size_t OFF_VT = 282066944;
constexpr size_t OFF_OF = 300941312;
constexpr size_t OFF_OB = 334495744;
constexpr size_t OFF_U = OFF_Z;
constexpr size_t OFF_GATES = 368050176;
constexpr size_t OFF_MODP = 369098752;
constexpr size_t OFF_MOD = 373030912;
constexpr size_t OFF_MISC = 373276672;
constexpr size_t OFF_BAR = OFF_MISC + 256;
constexpr size_t VT_SAMPLE = 4194304;

struct Params {
  const float *x_prompt, *x_sample, *cache_k, *cache_v, *state_fwd, *state_bwd, *c, *c_ctx, *mod_w, *mod_b,
      *norm_mix_g, *w_in, *conv_qkv_w, *lq1, *lk1, *lq2, *lk2, *subln_g, *a_log, *dt_bias, *dn_norm_g, *w_out,
      *norm_ffn_g, *w_up, *conv_ffn_w, *w_down, *final_g;
  float* out;
  char* ws;
  int phase_lo, phase_hi;
};

typedef __attribute__((ext_vector_type(4))) __bf16 hbf16x4;
DI u16 f2bf(float f) { return __builtin_bit_cast(u16, (__bf16)f); }
DI float bf2f(u16 h) { return __uint_as_float(((unsigned)h) << 16); }
DI float bf2f(short h) { return __uint_as_float(((unsigned)(u16)h) << 16); }
DI float silu_f(float x) { return x * __builtin_amdgcn_rcpf(1.f + __expf(-x)); }
DI int cvec_of(int tok) { return tok < NPR ? 4 : ((tok - NPR) >> 10); }
DI bf16x4 pack4(f32x4 v) { return __builtin_bit_cast(bf16x4, __builtin_convertvector(v, hbf16x4)); }

DI float4 ld4_bf(const u16* ptr) {
  const bf16x4 b = *(const bf16x4*)ptr;
  return make_float4(bf2f(b[0]), bf2f(b[1]), bf2f(b[2]), bf2f(b[3]));
}

DI void p0_gemv(const Params& p, int item, float* lds) {
  const int nch = item % 12, ks = item / 12, tid = threadIdx.x, lane = tid & 63;
  float sv[5][2];
#pragma unroll
  for (int v = 0; v < 5; ++v)
#pragma unroll
    for (int hh = 0; hh < 2; ++hh) {
      const int k = ks * 128 + hh * 64 + lane;
      sv[v][hh] = silu_f((v < 4) ? p.c[v * DM + k] : p.c_ctx[k]);
    }
  const int n = nch * 1024 + tid * 2;
  float a[5][2];
#pragma unroll
  for (int v = 0; v < 5; ++v) { a[v][0] = 0.f; a[v][1] = 0.f; }
  const float* w = p.mod_w + (size_t)(ks * 128) * 12288 + n;
#pragma unroll
  for (int hh = 0; hh < 2; ++hh) {
#pragma unroll 1
    for (int k0 = 0; k0 < 64; k0 += 16) {
      typedef __attribute__((ext_vector_type(2))) float f32x2_;
      f32x2_ wv[16];
#pragma unroll
      for (int kk = 0; kk < 16; ++kk) wv[kk] = __builtin_nontemporal_load((const f32x2_*)(w + (size_t)(hh * 64 + k0 + kk) * 12288));
#pragma unroll
      for (int kk = 0; kk < 16; ++kk)
#pragma unroll
        for (int v = 0; v < 5; ++v) {
          const float s = __shfl(sv[v][hh], k0 + kk);
          a[v][0] += s * wv[kk].x; a[v][1] += s * wv[kk].y;
        }
    }
  }
  float* modp = (float*)(p.ws + OFF_MODP);
#pragma unroll
  for (int v = 0; v < 5; ++v) {
    float b0 = 0.f, b1 = 0.f;
    if (ks == 0) { b0 = p.mod_b[n]; b1 = p.mod_b[n + 1]; }
    float2 o; o.x = a[v][0] + b0; o.y = a[v][1] + b1;
    *(float2*)(modp + (size_t)(ks * 5 + v) * 12288 + n) = o;
  }
}

struct TItem { const float* W; u16* Wt; int K, N, k0, n0, perm; };
DI TItem t_decode(const Params& p, int t) {
  TItem r;
  r.perm = 0;
  if (t < 464) { r.W = p.w_in; r.Wt = (u16*)(p.ws + OFF_WT_IN); r.K = DM; r.N = NIN; r.k0 = (t / 29) * 128; r.n0 = (t % 29) * 256; }
  else if (t < 592) { t -= 464; r.W = p.w_out; r.Wt = (u16*)(p.ws + OFF_WT_OUT); r.K = DM; r.N = DM; r.k0 = (t / 8) * 128; r.n0 = (t % 8) * 256; }
  else if (t < 1296) { t -= 592; r.W = p.w_up; r.Wt = (u16*)(p.ws + OFF_WT_UP); r.K = DM; r.N = NUP; r.k0 = (t / 44) * 128; r.n0 = (t % 44) * 256; r.perm = 1; }
  else { t -= 1296; r.W = p.w_down; r.Wt = (u16*)(p.ws + OFF_WT_DOWN); r.K = DFF; r.N = DM; r.k0 = (t / 8) * 128; r.n0 = (t % 8) * 256; }
  return r;
}
DI void t_load(const TItem& it, int tid, float4 (&v)[4][4]) {
#pragma unroll
  for (int sub = 0; sub < 4; ++sub)
#pragma unroll
    for (int i = 0; i < 4; ++i) {
      const int idx = tid + i * NTHR, kr = idx >> 4, c4 = idx & 15;
      int n = it.n0 + sub * 64 + c4 * 4;
      if (it.perm) n = (it.n0 >> 1) + (sub & 1) * 64 + c4 * 4 + (sub >> 1) * DFF;
      v[sub][i] = make_float4(0.f, 0.f, 0.f, 0.f);
      if (n < it.N) v[sub][i] = *(const float4*)(it.W + (size_t)(it.k0 + kr) * it.N + n);
    }
}
DI void t_store(const TItem& it, int tid, const float4 (&v)[4][4], u16* lds) {
#pragma unroll
  for (int sub = 0; sub < 4; ++sub)
#pragma unroll
    for (int i = 0; i < 4; ++i) {
      const int idx = tid + i * NTHR, kr = idx >> 4, c4 = idx & 15;
      u16* l = lds + (sub * 64 + c4 * 4) * 136 + (kr ^ ((c4 & 7) << 3));
      l[0] = f2bf(v[sub][i].x); l[136] = f2bf(v[sub][i].y); l[272] = f2bf(v[sub][i].z); l[408] = f2bf(v[sub][i].w);
    }
  __syncthreads();
#pragma unroll
  for (int sub = 0; sub < 4; ++sub) {
    const int n = sub * 64 + (tid >> 3), kc = tid & 7, sw = ((n >> 2) & 7) << 3;
    bf16x8 a = *(const bf16x8*)(lds + n * 136 + ((kc * 16) ^ sw));
    bf16x8 b2 = *(const bf16x8*)(lds + n * 136 + ((kc * 16 + 8) ^ sw));
    u16* dst = it.Wt + (size_t)(it.n0 + n) * it.K + it.k0 + kc * 16;
    *(bf16x8*)dst = a;
    *(bf16x8*)(dst + 8) = b2;
  }
}

DI void transposes_dyn(const Params& p, char* shm, int* ctr, int base, int soft_limit, int end, int max_items) {
  int tid_ = threadIdx.x;
  asm volatile("" : "+v"(tid_));
  const int tid = tid_;
  volatile int* s_next = (volatile int*)(shm + 131008);
  u16* lds = (u16*)shm;
  __syncthreads();
  if (tid == 0) *s_next = base + atomicAdd(ctr, 1);
  __syncthreads();
  int t = *s_next, taken = 1;
  float4 v[4][4];
  TItem cur = t_decode(p, t < end ? t : 0);
  if (t < end) t_load(cur, tid, v);
#pragma unroll 1
  while (t < end) {
    const bool more = (t < soft_limit) && (taken < max_items);
    __syncthreads();
    if (tid == 0) *s_next = more ? base + atomicAdd(ctr, 1) : end;
    __syncthreads();
    const int tn = *s_next;
    ++taken;
    float4 vn[4][4];
    TItem nxt = t_decode(p, tn < end ? tn : 0);
    if (tn < end) t_load(nxt, tid, vn);
    t_store(cur, tid, v, lds);
#pragma unroll
    for (int a_ = 0; a_ < 4; ++a_)
#pragma unroll
      for (int b_ = 0; b_ < 4; ++b_) v[a_][b_] = vn[a_][b_];
    cur = nxt; t = tn;
  }
  __syncthreads();
}

DI void phase0(const Params& p, char* shm) {
  const int tid = threadIdx.x;
  u16* kbuf = (u16*)(p.ws + OFF_KBUF);
  u16* vt = (u16*)(p.ws + OFF_VT);
  if (blockIdx.x < 192) p0_gemv(p, blockIdx.x, (float*)shm);
  for (int item = blockIdx.x; item < 768; item += gridDim.x) {
    if (item < 256) {
      int e = item * 4096 + tid * 8;
      int b = e >> 18, s = (e >> 10) & 255, cc = e & 1023;
      float4 v0 = *(const float4*)(p.cache_k + e), v1 = *(const float4*)(p.cache_k + e + 4);
      bf16x8 o;
      o[0] = (short)f2bf(v0.x); o[1] = (short)f2bf(v0.y); o[2] = (short)f2bf(v0.z); o[3] = (short)f2bf(v0.w);
      o[4] = (short)f2bf(v1.x); o[5] = (short)f2bf(v1.y); o[6] = (short)f2bf(v1.z); o[7] = (short)f2bf(v1.w);
      *(bf16x8*)(kbuf + (size_t)(NPR + b * 1280 + 1024 + s) * 1024 + cc) = o;
    } else {
      int idx = (item - 256) * NTHR + tid;
      int dv = idx & 127, h = (idx >> 7) & 7, s4 = (idx >> 10) & 63, b = idx >> 16;
      f32x4 v;
#pragma unroll
      for (int i = 0; i < 4; ++i) v[i] = p.cache_v[((size_t)(b * 256 + s4 * 4 + i) * 8 + h) * 128 + dv];
      *(bf16x4*)(vt + VT_SAMPLE + (size_t)((b * 8 + h) * 128 + dv) * 1280 + 1024 + s4 * 4) = pack4(v);
    }
  }
  transposes_dyn(p, shm, (int*)(p.ws + OFF_MISC + 64), 0, 592, 592, 1 << 30);
}

template <int MODE>
DI void norm_mod_phase(const Params& p, char* shm) {
  const int tid = threadIdx.x, lane = tid & 63, w = tid >> 6;
  float* sc = (float*)shm;
  float* sh = sc + DM;
  const float* modp = (const float*)(p.ws + OFF_MODP);
  float* mod = (float*)(p.ws + OFF_MOD);
  u16* dst = (u16*)(p.ws + OFF_ABUF);
  if (MODE == 0) {
    for (int i = blockIdx.x * NTHR + tid; i < 5 * 12288; i += gridDim.x * NTHR) {
      int v = i / 12288, n = i % 12288;
      float s = 0.f;
#pragma unroll
      for (int ks = 0; ks < 16; ++ks) s += modp[(size_t)(ks * 5 + v) * 12288 + n];
      mod[i] = s;
    }
  }
  for (int rb = blockIdx.x; rb < NTOK / 32; rb += gridDim.x) {
    const int row0 = rb * 32, cv = cvec_of(row0);
    __syncthreads();
    for (int k = tid; k < DM; k += NTHR) {
      float s_sh, s_sc, g;
      if (MODE == 0) {
        s_sh = 0.f; s_sc = 0.f;
#pragma unroll
        for (int ks = 0; ks < 16; ++ks) {
          s_sh += modp[(size_t)(ks * 5 + cv) * 12288 + k];
          s_sc += modp[(size_t)(ks * 5 + cv) * 12288 + 2048 + k];
        }
        g = p.norm_mix_g[k];
      } else {
        s_sh = mod[cv * 12288 + 6144 + k];
        s_sc = mod[cv * 12288 + 8192 + k];
        g = p.norm_ffn_g[k];
      }
      sc[k] = (1.f + s_sc) * g;
      sh[k] = s_sh;
    }
    __syncthreads();
#pragma unroll 1
    for (int i = 0; i < 4; ++i) {
      const int row = row0 + w * 4 + i;
      const float* src = (row < NPR) ? p.x_prompt + (size_t)row * DM : p.x_sample + (size_t)(row - NPR) * DM;
      const u16* srcb = (const u16*)(p.ws + OFF_X1B) + (size_t)row * DM;
      float4 v[8];
      float ss = 0.f;
#pragma unroll
      for (int ii = 0; ii < 8; ++ii) {
        if (MODE == 0) { const f32x4 t4 = __builtin_nontemporal_load((const f32x4*)(src + (ii * 64 + lane) * 4)); v[ii] = make_float4(t4[0], t4[1], t4[2], t4[3]); }
        else v[ii] = ld4_bf(srcb + (ii * 64 + lane) * 4);
        ss += v[ii].x * v[ii].x + v[ii].y * v[ii].y + v[ii].z * v[ii].z + v[ii].w * v[ii].w;
      }
#pragma unroll
      for (int o = 32; o > 0; o >>= 1) ss += __shfl_xor(ss, o);
      const float rs = rsqrtf(ss * (1.f / DM) + 1e-6f);
#pragma unroll
      for (int ii = 0; ii < 8; ++ii) {
        const int c = (ii * 64 + lane) * 4;
        f32x4 o;
        o[0] = v[ii].x * rs * sc[c] + sh[c];
        o[1] = v[ii].y * rs * sc[c + 1] + sh[c + 1];
        o[2] = v[ii].z * rs * sc[c + 2] + sh[c + 2];
        o[3] = v[ii].w * rs * sc[c + 3] + sh[c + 3];
        *(bf16x4*)(dst + (size_t)row * DM + c) = pack4(o);
      }
    }
  }
}

DI void final_norm_phase(const Params& p) {
  const int tid = threadIdx.x, lane = tid & 63, w = tid >> 6;
  for (int row = blockIdx.x * 8 + w; row < NTOK; row += gridDim.x * 8) {
    float* src = p.out + (size_t)row * DM;
    const u16* srcb = (const u16*)(p.ws + OFF_X1B) + (size_t)row * DM;
    float4 v[8];
    float ss = 0.f;
#pragma unroll
    for (int ii = 0; ii < 8; ++ii) {
      v[ii] = ld4_bf(srcb + (ii * 64 + lane) * 4);
      ss += v[ii].x * v[ii].x + v[ii].y * v[ii].y + v[ii].z * v[ii].z + v[ii].w * v[ii].w;
    }
#pragma unroll
    for (int o = 32; o > 0; o >>= 1) ss += __shfl_xor(ss, o);
    const float rs = rsqrtf(ss * (1.f / DM) + 1e-6f);
#pragma unroll
    for (int ii = 0; ii < 8; ++ii) {
      const int c = (ii * 64 + lane) * 4;
      float4 g = *(const float4*)(p.final_g + c);
      float4 o;
      o.x = v[ii].x * rs * g.x; o.y = v[ii].y * rs * g.y; o.z = v[ii].z * rs * g.z; o.w = v[ii].w * rs * g.w;
      { f32x4 ov = {o.x, o.y, o.z, o.w}; __builtin_nontemporal_store(ov, (f32x4*)(src + c)); }
    }
  }
}

#ifndef FILL_N
#define FILL_N 10
#endif
constexpr int BM = 256, BK = 64, HALF = 128, NXCD = 8, WGM = 8, HT = HALF * BK;

DI int lds_byte(int r, int c) {
  int st = (r >> 4) * 2 + (c >> 5), rr = r & 15, cc = c & 31, ob = rr * 64 + cc * 2;
  return st * 1024 + (ob ^ (((ob >> 9) & 1) << 5));
}
DI void stage_rc(int b, int& R, int& C) {
  int st = b / 1024, sb = b % 1024, swz = sb ^ (((sb >> 9) & 1) << 5);
  R = (st >> 1) * 16 + swz / 64; C = (st & 1) * 32 + (swz % 64) / 2;
}

template <int MODE>
DI void epi_read(const Params& p, const float* T, int rowbase, int bcol, int tid0) {
  int tid = tid0;
  asm volatile("" : "+v"(tid));
  const float* mod = (const float*)(p.ws + OFF_MOD);
  const int rsub = tid >> 5, cgp = tid & 31, c0 = (cgp >> 2) * 32 + (cgp & 3) * 4;
  const int gc0 = bcol + c0;
  if constexpr (MODE == 1) {
    const int pn = bcol >> 8;
    const bool sample = rowbase >= NPR;
    u16* Z = (u16*)(p.ws + OFF_Z);
    u16* kbuf = (u16*)(p.ws + OFF_KBUF);
    float* gates = (float*)(p.ws + OFF_GATES);
    const bool colpart = (cgp >> 2) & 1;
#pragma unroll 1
    for (int it = 0; it < 4; ++it) {
      const int lr = it * 16 + rsub;
      const int row = rowbase + (lr >> 5) * 64 + (lr & 31);
      f32x4 v0 = *(const f32x4*)(T + lr * 260 + c0), v1 = *(const f32x4*)(T + lr * 260 + c0 + 16);
      if (pn < 8) {
        if (!sample && pn >= 4) {
          *(f32x4*)(p.out + OUT_CK + (size_t)row * 1024 + gc0 - 1024) = v0;
          *(f32x4*)(p.out + OUT_CK + (size_t)row * 1024 + gc0 - 1024 + 16) = v1;
        }
        if (sample) {
          const int t = (row - NPR) & 1023;
          const float pos = (float)(colpart ? (t & 63) : (t >> 6));
#pragma unroll
          for (int e = 0; e < 4; ++e) {
            float sn, cs;
            __sincosf(pos * __builtin_amdgcn_exp2f(-(float)((cgp & 3) * 4 + e) * 0.830482024f), &sn, &cs);
            const float a = v0[e], b = v1[e];
            v0[e] = a * cs - b * sn;
            v1[e] = a * sn + b * cs;
          }
        }
        if (pn < 4) {
          *(bf16x4*)(Z + (size_t)row * NINP + gc0) = pack4(v0);
          *(bf16x4*)(Z + (size_t)row * NINP + gc0 + 16) = pack4(v1);
        } else {
          const int kr = sample ? (NPR + ((row - NPR) >> 10) * 1280 + ((row - NPR) & 1023)) : row;
          *(bf16x4*)(kbuf + (size_t)kr * 1024 + gc0 - 1024) = pack4(v0);
          *(bf16x4*)(kbuf + (size_t)kr * 1024 + gc0 - 1024 + 16) = pack4(v1);
        }
      } else if (pn < 12) {
        if (!sample) {
          *(f32x4*)(p.out + OUT_CV + (size_t)row * 1024 + gc0 - 2048) = v0;
          *(f32x4*)(p.out + OUT_CV + (size_t)row * 1024 + gc0 - 2048 + 16) = v1;
        }
      } else if (pn < 28) {
        *(bf16x4*)(Z + (size_t)row * NINP + gc0) = pack4(v0);
        *(bf16x4*)(Z + (size_t)row * NINP + gc0 + 16) = pack4(v1);
      } else {
        if (c0 < 16) {
          *(f32x4*)(gates + (size_t)row * 32 + c0) = v0;
          *(f32x4*)(gates + (size_t)row * 32 + c0 + 16) = v1;
        }
      }
    }
    if (pn >= 8 && pn < 12) {
      u16* vt = (u16*)(p.ws + OFF_VT);
      const int rgl = (tid >> 3) & 7, cl = (tid & 7) + 8 * (tid >> 6);
      const int ldk = sample ? 1280 : 256;
#pragma unroll 2
      for (int it = 0; it < 8; ++it) {
        const int lr = (rgl + 8 * (it & 1)) * 4;
        const int col = cl + 64 * (it >> 1);
        const int row = rowbase + (lr >> 5) * 64 + (lr & 31);
        size_t rowoff;
        if (!sample) rowoff = (size_t)((row >> 8) * 8) * 128 * 256 + (row & 255);
        else rowoff = VT_SAMPLE + (size_t)(((row - NPR) >> 10) * 8) * 128 * 1280 + ((row - NPR) & 1023);
        const int vc = bcol + col - 2048;
        f32x4 vv;
#pragma unroll
        for (int j = 0; j < 4; ++j) vv[j] = T[(lr + j) * 260 + col];
        *(bf16x4*)(vt + rowoff + (size_t)vc * ldk) = pack4(vv);
      }
    }
  } else if constexpr (MODE == 2 || MODE == 4) {
    const int cv = cvec_of(rowbase);
    const int goff = (MODE == 2) ? 4096 : 10240;
    const f32x4 g0 = *(const f32x4*)(mod + cv * 12288 + goff + gc0), g1 = *(const f32x4*)(mod + cv * 12288 + goff + gc0 + 16);
#pragma unroll
    for (int it = 0; it < 4; ++it) {
      const int lr = it * 16 + rsub;
      const int row = rowbase + (lr >> 5) * 64 + (lr & 31);
      const f32x4 v0 = *(const f32x4*)(T + lr * 260 + c0), v1 = *(const f32x4*)(T + lr * 260 + c0 + 16);
      u16* xb = (u16*)(p.ws + OFF_X1B) + (size_t)row * DM;
      f32x4 x0, x1;
      if (MODE == 2) {
        const float* xin = (row < NPR) ? p.x_prompt + (size_t)row * DM : p.x_sample + (size_t)(row - NPR) * DM;
        x0 = *(const f32x4*)(xin + gc0); x1 = *(const f32x4*)(xin + gc0 + 16);
      } else {
        const float4 a = ld4_bf(xb + gc0), b = ld4_bf(xb + gc0 + 16);
        x0 = f32x4{a.x, a.y, a.z, a.w}; x1 = f32x4{b.x, b.y, b.z, b.w};
      }
      *(bf16x4*)(xb + gc0) = pack4(x0 + g0 * v0);
      *(bf16x4*)(xb + gc0 + 16) = pack4(x1 + g1 * v1);
    }
  }
}

extern __shared__ __attribute__((aligned(16))) char g_shm[];

DI void gemm_epilogue_up(const Params& p, f32x4 (&acc)[2][2][4][2], int brow, int bcol, int wr, int wc, int fr, int fq, bool hm) {
  float* T = (float*)g_shm;
  u16* act = (u16*)(p.ws + OFF_ACT);
  u16* UB = (u16*)(p.ws + OFF_UB);
  int tid = threadIdx.x;
  asm volatile("" : "+v"(tid));
  const int pn = bcol >> 8;
  const int c4 = (tid & 31) * 4;
  float* WL = T + 64 * 260;
  if (tid < 192) {
    const int j = tid >> 6, q4 = (tid & 63) * 4;
    *(f32x4*)(WL + j * 256 + q4) = *(const f32x4*)(p.conv_ffn_w + j * NUP + (q4 < 128 ? pn * 128 + q4 : DFF + pn * 128 + q4 - 128));
  }
#pragma unroll
  for (int ps = 0; ps < 4; ++ps) {
    const int ai = ps >> 1, wsel = ps & 1;
    if (hm && ai == 1) continue;
    if (wr == wsel) {
      float* tp = T + (fq * 4) * 260 + wc * 32 + fr;
#pragma unroll
      for (int m = 0; m < 4; ++m)
#pragma unroll
        for (int bj = 0; bj < 2; ++bj)
#pragma unroll
          for (int n = 0; n < 2; ++n)
#pragma unroll
            for (int j = 0; j < 4; ++j) tp[(m * 16 + j) * 260 + bj * 128 + n * 16] = acc[ai][bj][m][n][j];
    }
    __syncthreads();
    const int rowbase = brow + ai * 128 + wsel * 64;
#pragma unroll 1
    for (int it = 0; it < 4; ++it) {
      const int lr = it * 16 + (tid >> 5);
      const int row = rowbase + lr;
      const f32x4 g0 = *(const f32x4*)(T + lr * 260 + c4), v0 = *(const f32x4*)(T + lr * 260 + 128 + c4);
      if (lr < 2 || lr >= 62) {
        const int slot = (row >> 6) * 4 + ((lr < 2) ? lr : lr - 60);
        *(bf16x4*)(UB + (size_t)slot * NUP + pn * 256 + c4) = pack4(g0);
        *(bf16x4*)(UB + (size_t)slot * NUP + pn * 256 + 128 + c4) = pack4(v0);
      }
      if (lr >= 1 && lr <= 62) {
        const f32x4 gm = *(const f32x4*)(T + (lr - 1) * 260 + c4), vm = *(const f32x4*)(T + (lr - 1) * 260 + 128 + c4);
        const f32x4 gp = *(const f32x4*)(T + (lr + 1) * 260 + c4), vp = *(const f32x4*)(T + (lr + 1) * 260 + 128 + c4);
        const f32x4 wg0 = *(const f32x4*)(WL + c4), wg1 = *(const f32x4*)(WL + 256 + c4), wg2 = *(const f32x4*)(WL + 512 + c4);
        const f32x4 wv0 = *(const f32x4*)(WL + 128 + c4), wv1 = *(const f32x4*)(WL + 384 + c4), wv2 = *(const f32x4*)(WL + 640 + c4);
        f32x4 o;
#pragma unroll
        for (int e = 0; e < 4; ++e) {
          const float gg = wg0[e] * gm[e] + wg1[e] * g0[e] + wg2[e] * gp[e];
          const float vv = wv0[e] * vm[e] + wv1[e] * v0[e] + wv2[e] * vp[e];
          o[e] = silu_f(gg) * vv;
        }
        *(bf16x4*)(act + (size_t)row * DFF + pn * 128 + c4) = pack4(o);
      }
    }
    __syncthreads();
  }
}

template <int MODE>
DI void gemm_epilogue(const Params& p, f32x4 (&acc)[2][2][4][2], int brow, int bcol, int wr, int wc, int fr, int fq, bool hm) {
  if constexpr (MODE == 3) { gemm_epilogue_up(p, acc, brow, bcol, wr, wc, fr, fq, hm); return; }
  float* T = (float*)g_shm;
#pragma unroll
  for (int ps = 0; ps < 4; ++ps) {
    const int ai = ps >> 1, mh = ps & 1;
    {
      float* tp = T + (wr * 32 + fq * 4) * 260 + wc * 32 + fr;
#pragma unroll
      for (int mm = 0; mm < 2; ++mm)
#pragma unroll
        for (int bj = 0; bj < 2; ++bj)
#pragma unroll
          for (int n = 0; n < 2; ++n)
#pragma unroll
            for (int j = 0; j < 4; ++j) tp[(mm * 16 + j) * 260 + bj * 128 + n * 16] = acc[ai][bj][mh * 2 + mm][n][j];
    }
    __syncthreads();
    epi_read<MODE>(p, T, brow + ai * 128 + mh * 32, bcol, (int)threadIdx.x);
    __syncthreads();
  }
}

template <int MODE>
DI void gemm_phase(const Params& p, const u16* __restrict__ A, const u16* __restrict__ Bt, int M, int N, int K) {
  u16* shm = (u16*)g_shm;
  int tix = threadIdx.x;
  asm volatile("" : "+v"(tix));
#define SA(b, h) (shm + ((b) * 2 + (h)) * HT)
#define SB(b, h) (shm + (4 + (b) * 2 + (h)) * HT)
#define STAGE(P, BASE, br, kt)                                                                      \
  do {                                                                                              \
    const char* _gb = (const char*)((BASE) + (long)(br) * K + (long)(kt) * BK);                     \
    __builtin_amdgcn_global_load_lds((const unsigned*)(_gb + voff0),                                \
        (__attribute__((address_space(3))) unsigned*)((char*)(P) + tix * 16), 16, 0, 0);    \
    __builtin_amdgcn_global_load_lds((const unsigned*)(_gb + voff1),                                \
        (__attribute__((address_space(3))) unsigned*)((char*)(P) + tix * 16 + 8192), 16, 0, 0); \
  } while (0)
#define LDA(dst, b, h) for (int m = 0; m < 4; ++m) for (int k = 0; k < 2; ++k) \
    dst[m][k] = *reinterpret_cast<const bf16x8*>((char*)SA(b, h) + lds_byte(wr * 64 + m * 16 + fr, k * 32 + fq * 8))
#define LDB(dst, b, h) for (int n = 0; n < 2; ++n) for (int k = 0; k < 2; ++k) \
    dst[n][k] = *reinterpret_cast<const bf16x8*>((char*)SB(b, h) + lds_byte(wc * 32 + n * 16 + fr, k * 32 + fq * 8))
#define MMA(ai, bj, At, Bt_)                                                                        \
  do {                                                                                              \
    __builtin_amdgcn_s_setprio(1);                                                                  \
    for (int m = 0; m < 4; ++m) for (int n = 0; n < 2; ++n) for (int k = 0; k < 2; ++k)             \
      acc[ai][bj][m][n] = __builtin_amdgcn_mfma_f32_16x16x32_bf16(At[m][k], Bt_[n][k], acc[ai][bj][m][n], 0, 0, 0); \
    __builtin_amdgcn_s_setprio(0);                                                                  \
  } while (0)
#define WAIT_V(n) asm volatile("s_waitcnt vmcnt(" #n ")" ::: "memory")
#define WAIT_L(n) asm volatile("s_waitcnt lgkmcnt(" #n ")" ::: "memory")
#define BAR __builtin_amdgcn_s_barrier()
#define SCHED __builtin_amdgcn_sched_barrier(0)

  const int nM = M / BM, nN = N / BM, nwg = nM * nN;
  const int wid = __builtin_amdgcn_readfirstlane(tix >> 6), lane = tix & 63, wr = wid >> 2, wc = wid & 3, fr = lane & 15, fq = lane >> 4;
  const int nt = K / BK;
  unsigned voff0, voff1;
  { int _r, _c; stage_rc(tix * 16, _r, _c); voff0 = (unsigned)(_r * K + _c) * 2u;
    stage_rc(tix * 16 + 8192, _r, _c); voff1 = (unsigned)(_r * K + _c) * 2u; }
  const int G_ = (int)gridDim.x, rem_ = nwg % G_;
  const bool split = (MODE == 3) && rem_ > 0 && rem_ * 2 <= G_;
  const int nfull = split ? nwg - rem_ : nwg, nunits = nfull + (split ? 2 * rem_ : 0);
#pragma unroll 1
  for (int unit = blockIdx.x; unit < nunits; unit += gridDim.x) {
    asm volatile("" : "+v"(voff0), "+v"(voff1));
    const bool hm = unit >= nfull;
    const int tile = hm ? nfull + ((unit - nfull) >> 1) : unit, hsel = hm ? ((unit - nfull) & 1) : 0;
    int wgid = tile;
    { int q = nwg / NXCD, r = nwg % NXCD, xcd = wgid % NXCD, off = wgid / NXCD;
      wgid = (xcd < r ? xcd * (q + 1) : r * (q + 1) + (xcd - r) * q) + off; }
    const int nig = WGM * nN, gid = wgid / nig, fm = gid * WGM, gsz = min(nM - fm, WGM);
    const int pm = fm + ((wgid % nig) % gsz), pn = (wgid % nig) / gsz, brow = pm * BM + hsel * HALF, bcol = pn * BM;
    const int brow2 = hm ? brow : brow + HALF;
    f32x4 acc[2][2][4][2] = {};
    bf16x8 At[4][2], B0[2][2], B1[2][2];
    STAGE(SB(0, 0), Bt, bcol, 0); STAGE(SA(0, 0), A, brow, 0);
    STAGE(SB(0, 1), Bt, bcol + HALF, 0); STAGE(SA(0, 1), A, brow2, 0);
    if (wr == 1) BAR;
    WAIT_V(4); BAR;
    STAGE(SB(1, 0), Bt, bcol, 1); STAGE(SA(1, 0), A, brow, 1); STAGE(SB(1, 1), Bt, bcol + HALF, 1);
    WAIT_V(6); BAR;
#pragma unroll 1
    for (int t = 0; t < nt - 2; t += 2) {
      LDB(B0, 0, 0); SCHED; LDA(At, 0, 0); STAGE(SA(1, 1), A, brow2, t + 1);
      WAIT_L(8); BAR; WAIT_L(0); MMA(0, 0, At, B0); BAR; SCHED;
      LDB(B1, 0, 1); STAGE(SB(0, 0), Bt, bcol, t + 2);
      BAR; WAIT_L(0); MMA(0, 1, At, B1); BAR;
      if (!hm) { LDA(At, 0, 1); } STAGE(SA(0, 0), A, brow, t + 2);
      BAR; WAIT_L(0); if (!hm) MMA(1, 0, At, B0); BAR; SCHED;
      STAGE(SB(0, 1), Bt, bcol + HALF, t + 2);
      WAIT_V(6); BAR; if (!hm) MMA(1, 1, At, B1); BAR;
      LDB(B0, 1, 0); SCHED; LDA(At, 1, 0); STAGE(SA(0, 1), A, brow2, t + 2);
      WAIT_L(8); BAR; WAIT_L(0); MMA(0, 0, At, B0); BAR; SCHED;
      LDB(B1, 1, 1); STAGE(SB(1, 0), Bt, bcol, t + 3);
      BAR; WAIT_L(0); MMA(0, 1, At, B1); BAR;
      if (!hm) { LDA(At, 1, 1); } STAGE(SA(1, 0), A, brow, t + 3);
      BAR; WAIT_L(0); if (!hm) MMA(1, 0, At, B0); BAR; SCHED;
      STAGE(SB(1, 1), Bt, bcol + HALF, t + 3);
      WAIT_V(6); BAR; if (!hm) MMA(1, 1, At, B1); BAR;
    }
    { LDB(B0, 0, 0); LDA(At, 0, 0); STAGE(SA(1, 1), A, brow2, nt - 1);
      BAR; WAIT_L(0); MMA(0, 0, At, B0); BAR;
      LDB(B1, 0, 1); BAR; WAIT_L(0); MMA(0, 1, At, B1); BAR;
      if (!hm) { LDA(At, 0, 1); } WAIT_V(4); BAR; WAIT_L(0); if (!hm) { MMA(1, 0, At, B0); MMA(1, 1, At, B1); } BAR; }
    { LDB(B0, 1, 0); LDA(At, 1, 0); WAIT_V(2); BAR; WAIT_L(0); MMA(0, 0, At, B0); BAR;
      LDB(B1, 1, 1); WAIT_V(0); BAR; WAIT_L(0); MMA(0, 1, At, B1); BAR;
      if (!hm) { LDA(At, 1, 1); } BAR; WAIT_L(0); if (!hm) { MMA(1, 0, At, B0); MMA(1, 1, At, B1); } BAR; }
    if (wr == 0) BAR;
    gemm_epilogue<MODE>(p, acc, brow, bcol, wr, wc, fr, fq, hm);
  }
  if constexpr (MODE == 1 || MODE == 3) {
    const int rounds = (nunits + (int)gridDim.x - 1) / (int)gridDim.x;
    const int mine = (nunits - (int)blockIdx.x + (int)gridDim.x - 1) / (int)gridDim.x;
    if (mine < rounds) transposes_dyn(p, g_shm, (int*)(p.ws + OFF_MISC + 128), 592, 1648, 1648, FILL_N);
  }
#undef SA
#undef SB
}

#define MFMA16(a, b, c) __builtin_amdgcn_mfma_f32_16x16x32_bf16((a), (b), (c), 0, 0, 0)

DI void attn_item(const Params& p, int a, char* shm, float lam) {
  int tid_ = threadIdx.x;
  asm volatile("" : "+v"(tid_));
  const int tid = tid_, lane = tid & 63, w = __builtin_amdgcn_readfirstlane(tid >> 6), fr = lane & 15, fq = lane >> 4;
  const u16* Z = (const u16*)(p.ws + OFF_Z);
  const u16* kbuf = (const u16*)(p.ws + OFF_KBUF);
  const u16* vtg = (const u16*)(p.ws + OFF_VT);
  u16* obuf = (u16*)(p.ws + OFF_ABUF);
  int b, h, qtok0, krow0, nk, LK;
  const u16* vt;
  if (a < 256) {
    b = a >> 6; h = (a >> 3) & 7; const int qb = a & 7;
    qtok0 = NPR + b * 1024 + qb * 128; krow0 = NPR + b * 1280; nk = 1280; LK = 1280;
    vt = vtg + VT_SAMPLE + (size_t)((b * 8 + h) * 128) * 1280;
  } else {
    const int a2 = a - 256;
    b = a2 >> 4; h = (a2 >> 1) & 7; const int qb = a2 & 1;
    qtok0 = b * 256 + qb * 128; krow0 = b * 256; nk = 256; LK = 256;
    vt = vtg + (size_t)((b * 8 + h) * 128) * 256;
  }
  u16* Kl = (u16*)shm;
  u16* Vl = (u16*)(shm + 17408);
  bf16x8 qf[2][2];
  {
    const u16* qp = Z + (size_t)(qtok0 + w * 16 + fr) * NINP + h * 128 + fq * 8;
#pragma unroll
    for (int mp = 0; mp < 2; ++mp)
#pragma unroll
      for (int ks = 0; ks < 2; ++ks) qf[mp][ks] = *(const bf16x8*)(qp + mp * 64 + ks * 32);
  }
  f32x4 O[2][8];
#pragma unroll
  for (int mp = 0; mp < 2; ++mp)
#pragma unroll
    for (int dt = 0; dt < 8; ++dt) O[mp][dt] = f32x4{0.f, 0.f, 0.f, 0.f};
  float mx[2] = {-1e30f, -1e30f}, ls[2] = {0.f, 0.f};
  const float SC = 0.125f * 1.44269504089f;
  const u16* kg = kbuf + (size_t)(krow0 + (tid >> 4)) * 1024 + h * 128 + (tid & 15) * 8;
  const u16* vg = vt + (size_t)(tid >> 3) * LK + (tid & 7) * 8;
  bf16x8 kr0 = *(const bf16x8*)(kg), kr1 = *(const bf16x8*)(kg + 32 * 1024);
  bf16x8 vr0 = *(const bf16x8*)(vg), vr1 = *(const bf16x8*)(vg + (size_t)64 * LK);
  const int ntile = nk >> 6;
  __syncthreads();
  *(bf16x8*)(Kl + (tid >> 4) * 136 + (tid & 15) * 8) = kr0;
  *(bf16x8*)(Kl + ((tid >> 4) + 32) * 136 + (tid & 15) * 8) = kr1;
  *(bf16x8*)(Vl + (tid >> 3) * 72 + (tid & 7) * 8) = vr0;
  *(bf16x8*)(Vl + ((tid >> 3) + 64) * 72 + (tid & 7) * 8) = vr1;
  __syncthreads();
#pragma unroll 1
  for (int kt = 0; kt < ntile; ++kt) {
    Kl = (u16*)(shm + (kt & 1) * 35840);
    Vl = (u16*)(shm + (kt & 1) * 35840 + 17408);
    if (kt + 1 < ntile) {
      kr0 = *(const bf16x8*)(kg + (size_t)(kt + 1) * 64 * 1024);
      kr1 = *(const bf16x8*)(kg + (size_t)(kt + 1) * 64 * 1024 + 32 * 1024);
      vr0 = *(const bf16x8*)(vg + (kt + 1) * 64);
      vr1 = *(const bf16x8*)(vg + (size_t)64 * LK + (kt + 1) * 64);
    }
    bf16x8 pb[2][2];
#pragma unroll
    for (int mp = 0; mp < 2; ++mp) {
      f32x4 s[4];
#pragma unroll
      for (int t16 = 0; t16 < 4; ++t16) {
        s[t16] = f32x4{0.f, 0.f, 0.f, 0.f};
#pragma unroll
        for (int ks = 0; ks < 2; ++ks) {
          bf16x8 ka = *(const bf16x8*)(Kl + (t16 * 16 + fr) * 136 + mp * 64 + ks * 32 + fq * 8);
          s[t16] = MFMA16(ka, qf[mp][ks], s[t16]);
        }
      }
      float tm = -1e30f;
#pragma unroll
      for (int t16 = 0; t16 < 4; ++t16)
#pragma unroll
        for (int j = 0; j < 4; ++j) tm = fmaxf(tm, s[t16][j]);
      tm *= SC;
      tm = fmaxf(tm, __shfl_xor(tm, 16));
      tm = fmaxf(tm, __shfl_xor(tm, 32));
      const float mnew = fmaxf(mx[mp], tm);
      const float alpha = __builtin_amdgcn_exp2f(mx[mp] - mnew);
      mx[mp] = mnew;
      float lsum = 0.f;
#pragma unroll
      for (int t16 = 0; t16 < 4; ++t16)
#pragma unroll
        for (int j = 0; j < 4; ++j) {
          const float pv = __builtin_amdgcn_exp2f(s[t16][j] * SC - mnew);
          s[t16][j] = pv;
          lsum += pv;
        }
      ls[mp] = ls[mp] * alpha + lsum;
#pragma unroll
      for (int dt = 0; dt < 8; ++dt) {
        O[mp][dt][0] *= alpha; O[mp][dt][1] *= alpha; O[mp][dt][2] *= alpha; O[mp][dt][3] *= alpha;
      }
#pragma unroll
      for (int hf = 0; hf < 2; ++hf) {
        bf16x4 lo = pack4(s[2 * hf]), hi = pack4(s[2 * hf + 1]);
        pb[mp][hf] = bf16x8{lo[0], lo[1], lo[2], lo[3], hi[0], hi[1], hi[2], hi[3]};
      }
    }
#pragma unroll
    for (int hf = 0; hf < 2; ++hf)
#pragma unroll
      for (int dt = 0; dt < 8; ++dt) {
        bf16x4 va = *(const bf16x4*)(Vl + (dt * 16 + fr) * 72 + hf * 32 + fq * 4);
        bf16x4 vb = *(const bf16x4*)(Vl + (dt * 16 + fr) * 72 + hf * 32 + 16 + fq * 4);
        bf16x8 av = bf16x8{va[0], va[1], va[2], va[3], vb[0], vb[1], vb[2], vb[3]};
        O[0][dt] = MFMA16(av, pb[0][hf], O[0][dt]);
        O[1][dt] = MFMA16(av, pb[1][hf], O[1][dt]);
      }
    if (kt + 1 < ntile) {
      u16* Kn = (u16*)(shm + ((kt + 1) & 1) * 35840);
      u16* Vn = (u16*)(shm + ((kt + 1) & 1) * 35840 + 17408);
      *(bf16x8*)(Kn + (tid >> 4) * 136 + (tid & 15) * 8) = kr0;
      *(bf16x8*)(Kn + ((tid >> 4) + 32) * 136 + (tid & 15) * 8) = kr1;
      *(bf16x8*)(Vn + (tid >> 3) * 72 + (tid & 7) * 8) = vr0;
      *(bf16x8*)(Vn + ((tid >> 3) + 64) * 72 + (tid & 7) * 8) = vr1;
    }
    __syncthreads();
  }
  float l0 = ls[0], l1 = ls[1];
  l0 += __shfl_xor(l0, 16); l0 += __shfl_xor(l0, 32);
  l1 += __shfl_xor(l1, 16); l1 += __shfl_xor(l1, 32);
  const float i0 = 1.f / l0, i1 = lam / l1;
  float ss = 0.f;
#pragma unroll
  for (int dt = 0; dt < 8; ++dt)
#pragma unroll
    for (int j = 0; j < 4; ++j) {
      const float o = O[0][dt][j] * i0 - O[1][dt][j] * i1;
      O[0][dt][j] = o;
      ss += o * o;
    }
  ss += __shfl_xor(ss, 16); ss += __shfl_xor(ss, 32);
  const float rs = rsqrtf(ss * (1.f / 128.f) + 1e-6f) * 0.8f;
  u16* op = obuf + (size_t)(qtok0 + w * 16 + fr) * DM + h * 128 + fq * 4;
#pragma unroll
  for (int dt = 0; dt < 8; ++dt) {
    float4 g = *(const float4*)(p.subln_g + dt * 16 + fq * 4);
    f32x4 o;
    o[0] = O[0][dt][0] * rs * g.x; o[1] = O[0][dt][1] * rs * g.y; o[2] = O[0][dt][2] * rs * g.z; o[3] = O[0][dt][3] * rs * g.w;
    *(bf16x4*)(op + dt * 16) = pack4(o);
  }
}

DI void ld16(const u16* ptr, bool valid, float (&x)[16]) {
  bf16x8 a = {0, 0, 0, 0, 0, 0, 0, 0}, b = {0, 0, 0, 0, 0, 0, 0, 0};
  if (valid) { a = *(const bf16x8*)ptr; b = *(const bf16x8*)(ptr + 8); }
#pragma unroll
  for (int e = 0; e < 8; ++e) { x[e] = bf2f(a[e]); x[8 + e] = bf2f(b[e]); }
}
template <int PART>
DI void conv16(const u16* zr, bool hasm, bool hasp, const float* cw, int pp, float (&y)[16]) {
  float xm[16], x0[16], xp[16];
  ld16(zr + PART * 1024 - NINP, hasm, xm);
  ld16(zr + PART * 1024, true, x0);
  ld16(zr + PART * 1024 + NINP, hasp, xp);
#pragma unroll
  for (int c = 0; c < 16; ++c) {
    const int cc = PART * 128 + pp * 16 + c;
    y[c] = silu_f(cw[cc] * xm[c] + cw[384 + cc] * x0[c] + cw[768 + cc] * xp[c]);
  }
}
DI bf16x8 cat44(bf16x4 a, bf16x4 b) { return bf16x8{a[0], a[1], a[2], a[3], b[0], b[1], b[2], b[3]}; }

constexpr size_t OFF_VC = OFF_WT_IN;
DI void dn_prep_phase(const Params& p, char* shm) {
  int tid_ = threadIdx.x;
  asm volatile("" : "+v"(tid_));
  const int tid = tid_;
  u16* Z = (u16*)(p.ws + OFF_Z);
  u16* VC = (u16*)(p.ws + OFF_VC);
  float* gates = (float*)(p.ws + OFF_GATES);
  float* cw = (float*)shm;
  __syncthreads();
  for (int i = tid; i < 9216; i += NTHR) cw[i] = p.conv_qkv_w[i];
  __syncthreads();
  {
    const int lane = tid & 63, wv = __builtin_amdgcn_readfirstlane(tid >> 6);
#pragma unroll 1
    for (int task = blockIdx.x * 8 + wv; task < 2048; task += gridDim.x * 8) {
      const int chunk = task >> 4, j = task & 15, dirj = j >> 3;
      const size_t tk = (size_t)chunk * 64 + (dirj ? 63 - lane : lane);
      const float bb = gates[tk * 32 + j];
      const float aa = gates[tk * 32 + 16 + j] + p.dt_bias[j];
      const float sp = aa > 20.f ? aa : log1pf(__expf(aa));
      float g = -__expf(p.a_log[j]) * sp;
#pragma unroll
      for (int o = 1; o < 64; o <<= 1) {
        float t = __shfl_up(g, o);
        if (lane >= o) g += t;
      }
      gates[tk * 32 + j] = 1.f / (1.f + __expf(-bb));
      gates[tk * 32 + 16 + j] = g;
    }
  }
  const int tl = tid >> 6, h = (tid >> 3) & 7, pp = tid & 7;
#pragma unroll 1
  for (int it = blockIdx.x; it < NTOK / 8; it += gridDim.x) {
    const int tok = it * 8 + tl;
    const int tn = tok < NPR ? (tok & 255) : ((tok - NPR) & 1023);
    const int T = tok < NPR ? 256 : 1024;
    const bool hasm = tn > 0, hasp = tn < T - 1;
    const u16* zr = Z + (size_t)tok * NINP + 3072 + h * 128 + pp * 16;
    bf16x8 t0, t1;
#pragma unroll
    for (int part = 0; part < 3; ++part) {
      float xm[16], x0[16], xp[16], y[16];
      ld16(zr + part * 1024 - NINP, hasm, xm);
      ld16(zr + part * 1024, true, x0);
      ld16(zr + part * 1024 + NINP, hasp, xp);
      const float* w0 = cw + part * 1024 + h * 128 + pp * 16;
      float ss = 0.f;
#pragma unroll
      for (int c = 0; c < 16; ++c) {
        y[c] = silu_f(w0[c] * xm[c] + w0[3072 + c] * x0[c] + w0[6144 + c] * xp[c]);
        ss += y[c] * y[c];
      }
      float sc = 1.f;
      if (part < 2) {
#pragma unroll
        for (int o = 1; o < 8; o <<= 1) ss += __shfl_xor(ss, o);
        sc = rsqrtf(ss + 1e-6f) * (part == 0 ? 0.08838834764831845f : 1.f);
      }
#pragma unroll
      for (int c = 0; c < 8; ++c) { t0[c] = (short)f2bf(y[c] * sc); t1[c] = (short)f2bf(y[8 + c] * sc); }
      u16* dst = (part == 0) ? Z + (size_t)tok * NINP + 1024 + h * 128 + pp * 16
               : (part == 1) ? Z + (size_t)tok * NINP + 2048 + h * 128 + pp * 16
                             : VC + (size_t)tok * 1024 + h * 128 + pp * 16;
      *(bf16x8*)dst = t0;
      *(bf16x8*)(dst + 8) = t1;
    }
  }
}

#ifndef DNSEL
#define DNSEL 31
#endif
DI void dn_item(const Params& p, int seq, int h, int dir, char* shm) {
  int tid_ = threadIdx.x;
  asm volatile("" : "+v"(tid_));
  const int tid = tid_, lane = tid & 63, w = __builtin_amdgcn_readfirstlane(tid >> 6), fr = lane & 15, fq = lane >> 4;
  const int tid0 = tid, fr0 = fr, fq0 = fq;
#define LANE_VARS int tid = tid0, fr = fr0, fq = fq0; asm volatile("" : "+v"(tid), "+v"(fr), "+v"(fq));
  const bool sample = seq >= 16;
  const int T = sample ? 1024 : 256;
  const int tokbase = sample ? NPR + (seq - 16) * 1024 : seq * 256;
  const int nch = T >> 6;
  const u16* Z = (const u16*)(p.ws + OFF_Z);
  const float* gates = (const float*)(p.ws + OFF_GATES);
  float* obuf = (float*)(p.ws + (dir ? OFF_OB : OFF_OF));
  u16* qs = (u16*)(shm);
  u16* ksl = (u16*)(shm + 17408);
  u16* kdT = (u16*)(shm + 34816);
  u16* R = (u16*)(shm + 53248);
  float* Ad = (float*)(shm + 87040);
  u16* Abf = (u16*)(shm + 91136);
  u16* TinvL = (u16*)(shm + 100352);
  u16* qkm = (u16*)(shm + 102912);
  float* cw = (float*)(shm + 112128);
  float* gcs = (float*)(shm + 116736);
  float* betas = (float*)(shm + 116992);
  float* graw = (float*)(shm + 117248);
  u16* qs2 = (u16*)(shm + 117760);
  u16* kdT2 = (u16*)(shm + 135168);
  float* gcs2 = (float*)(shm + 153600);
  float* betas2 = (float*)(shm + 153856);
  __syncthreads();
  const u16* VC = (const u16*)(p.ws + OFF_VC);
  bf16x8 cq0, cq1, ck0, ck1, cv0, cv1;
  float pb_ = 0.f, pg = 0.f, pgl = 0.f;
  {
    const int ip = tid >> 3, pp = tid & 7;
    const int cn0 = dir ? nch - 1 : 0;
    const size_t tok0 = (size_t)tokbase + cn0 * 64 + (dir ? 63 - ip : ip);
    const u16* zq = Z + tok0 * NINP + 1024 + h * 128 + pp * 16;
    cq0 = *(const bf16x8*)zq; cq1 = *(const bf16x8*)(zq + 8);
    ck0 = *(const bf16x8*)(zq + 1024); ck1 = *(const bf16x8*)(zq + 1032);
    const u16* vq = VC + tok0 * 1024 + h * 128 + pp * 16;
    cv0 = *(const bf16x8*)vq; cv1 = *(const bf16x8*)(vq + 8);
    pb_ = gates[tok0 * 32 + dir * 8 + h]; pg = gates[tok0 * 32 + 16 + dir * 8 + h];
    pgl = gates[((size_t)tokbase + cn0 * 64 + (dir ? 0 : 63)) * 32 + 16 + dir * 8 + h];
  }
  f32x4 S[8];
  if (sample) {
    const float* s0 = (dir ? p.state_bwd : p.state_fwd) + (size_t)((seq - 16) * 8 + h) * 16384;
#pragma unroll
    for (int dt = 0; dt < 8; ++dt)
#pragma unroll
      for (int j = 0; j < 4; ++j) S[dt][j] = s0[(dt * 16 + fq * 4 + j) * 128 + w * 16 + fr];
  } else {
#pragma unroll
    for (int dt = 0; dt < 8; ++dt) S[dt] = f32x4{0.f, 0.f, 0.f, 0.f};
  }

#define DN_A1(QSN, KDN, GCN, BTN)                                                                   \
  do {                                                                                              \
    const int ip = tid >> 3, pp = tid & 7;                                                          \
    const float gci = pg, glast = pgl;                                                              \
    if (pp == 0) { (GCN)[ip] = gci; (BTN)[ip] = pb_; }                                              \
    const float ekd = __expf(glast - gci);                                                          \
    *(bf16x8*)((QSN) + ip * 136 + pp * 16) = cq0; *(bf16x8*)((QSN) + ip * 136 + pp * 16 + 8) = cq1; \
    *(bf16x8*)(ksl + ip * 136 + pp * 16) = ck0; *(bf16x8*)(ksl + ip * 136 + pp * 16 + 8) = ck1;      \
    _Pragma("unroll") for (int c = 0; c < 8; ++c) {                                                 \
      (KDN)[(pp * 16 + c) * 72 + (ip ^ (pp << 3))] = f2bf(bf2f(ck0[c]) * ekd);                      \
      (KDN)[(pp * 16 + 8 + c) * 72 + (ip ^ (pp << 3))] = f2bf(bf2f(ck1[c]) * ekd);                  \
    }                                                                                               \
  } while (0)
#define DN_A2(NEXT_OK, CN2)                                                                         \
  do {                                                                                              \
    const int ip = tid >> 3, pp = tid & 7;                                                          \
    const float beta = pb_, bk = pb_ * __expf(pg);                                                  \
    bf16x8 t0, t1;                                                                                  \
    _Pragma("unroll") for (int c = 0; c < 8; ++c) { t0[c] = (short)f2bf(bf2f(ck0[c]) * bk); t1[c] = (short)f2bf(bf2f(ck1[c]) * bk); } \
    *(bf16x8*)(R + ip * 264 + 128 + pp * 16) = t0; *(bf16x8*)(R + ip * 264 + 128 + pp * 16 + 8) = t1; \
    _Pragma("unroll") for (int c = 0; c < 8; ++c) { t0[c] = (short)f2bf(bf2f(cv0[c]) * beta); t1[c] = (short)f2bf(bf2f(cv1[c]) * beta); } \
    *(bf16x8*)(R + ip * 264 + pp * 16) = t0; *(bf16x8*)(R + ip * 264 + pp * 16 + 8) = t1;          \
    if (NEXT_OK) {                                                                                  \
      const int cn2 = (CN2);                                                                        \
      const size_t tok2 = (size_t)tokbase + cn2 * 64 + (dir ? 63 - ip : ip);                        \
      const u16* zq = Z + tok2 * NINP + 1024 + h * 128 + pp * 16;                                   \
      cq0 = *(const bf16x8*)zq; cq1 = *(const bf16x8*)(zq + 8);                                     \
      ck0 = *(const bf16x8*)(zq + 1024); ck1 = *(const bf16x8*)(zq + 1032);                         \
      const u16* vq = VC + tok2 * 1024 + h * 128 + pp * 16;                                         \
      cv0 = *(const bf16x8*)vq; cv1 = *(const bf16x8*)(vq + 8);                                     \
      pb_ = gates[tok2 * 32 + dir * 8 + h]; pg = gates[tok2 * 32 + 16 + dir * 8 + h];               \
      pgl = gates[((size_t)tokbase + cn2 * 64 + (dir ? 0 : 63)) * 32 + 16 + dir * 8 + h];           \
    }                                                                                               \
  } while (0)
  const bf16x4 z4 = {0, 0, 0, 0};
  {
    LANE_VARS
    DN_A1(qs, kdT, gcs, betas);
    DN_A2(true, (dir ? nch - 2 : 1));
  }
  __syncthreads();
#pragma unroll 1
  for (int s = 0; s < nch; ++s) {
    const int cn = dir ? nch - 1 - s : s;
    u16* qsc = (s & 1) ? qs2 : qs;   u16* qsn = (s & 1) ? qs : qs2;
    u16* kdc = (s & 1) ? kdT2 : kdT; u16* kdn = (s & 1) ? kdT : kdT2;
    float* gcc = (s & 1) ? gcs2 : gcs;     float* gcn = (s & 1) ? gcs : gcs2;
    float* btc = (s & 1) ? betas2 : betas; float* btn = (s & 1) ? betas : betas2;
    if (s > 0) {
      LANE_VARS
      DN_A2(s + 1 < nch, (dir ? nch - 2 - s : s + 1));
    }
    if (DNSEL & 2) {
      LANE_VARS
      const int ti = w >> 1;
#pragma unroll
      for (int tjj = 0; tjj < 2; ++tjj) {
        const int tj = (w & 1) * 2 + tjj;
        f32x4 akk = f32x4{0.f, 0.f, 0.f, 0.f}, aqk = f32x4{0.f, 0.f, 0.f, 0.f};
#pragma unroll
        for (int ks = 0; ks < 4; ++ks) {
          bf16x8 ak = *(const bf16x8*)(ksl + (ti * 16 + fr) * 136 + ks * 32 + fq * 8);
          bf16x8 aq = *(const bf16x8*)(qsc + (ti * 16 + fr) * 136 + ks * 32 + fq * 8);
          bf16x8 bk = *(const bf16x8*)(ksl + (tj * 16 + fr) * 136 + ks * 32 + fq * 8);
          akk = MFMA16(ak, bk, akk);
          aqk = MFMA16(aq, bk, aqk);
        }
        const int jj = tj * 16 + fr;
        const float gj = gcc[jj];
#pragma unroll
        for (int j = 0; j < 4; ++j) {
          const int i = ti * 16 + fq * 4 + j;
          const float e = (i >= jj) ? __expf(gcc[i] - gj) : 0.f;
          const float av = (i > jj) ? btc[i] * akk[j] * e : 0.f;
          Abf[i * 72 + jj] = f2bf(-av);
          if (ti == tj) Ad[(ti * 16 + fq * 4 + j) * 16 + fr] = av;
          qkm[i * 72 + jj] = f2bf(aqk[j] * e);
        }
        if (ti == tj) {
          asm volatile("s_waitcnt lgkmcnt(0)" ::: "memory");
          __builtin_amdgcn_wave_barrier();
          if (lane < 16) {
            const float* ab = Ad + ti * 256;
            f32x4 av[16][4];
#pragma unroll
            for (int i = 1; i < 16; ++i)
#pragma unroll
              for (int q = 0; q < (i + 3) / 4; ++q) av[i][q] = *(const f32x4*)(ab + i * 16 + q * 4);
            float x[16];
#pragma unroll
            for (int i = 0; i < 16; ++i) {
              float a = (i == lane) ? 1.f : 0.f;
#pragma unroll
              for (int j = 0; j < i; ++j) a -= av[i][j >> 2][j & 3] * x[j];
              x[i] = a;
              TinvL[(ti * 16 + i) * 20 + lane] = f2bf(a);
            }
          }
        }
      }
    }
    __syncthreads();
    if (DNSEL & 8) {
      LANE_VARS
      bf16x4 a10, a20, a21, a30, a31, a32, ti[4];
      {
        const u16* ar = Abf + fr * 72 + fq * 4;
        a10 = *(const bf16x4*)(ar + 16 * 72);
        a20 = *(const bf16x4*)(ar + 32 * 72); a21 = *(const bf16x4*)(ar + 32 * 72 + 16);
        a30 = *(const bf16x4*)(ar + 48 * 72); a31 = *(const bf16x4*)(ar + 48 * 72 + 16); a32 = *(const bf16x4*)(ar + 48 * 72 + 32);
#pragma unroll
        for (int t = 0; t < 4; ++t) ti[t] = *(const bf16x4*)(TinvL + (t * 16 + fr) * 20 + fq * 4);
      }
      f32x4 rhs[2][4];
#pragma unroll
      for (int cti = 0; cti < 2; ++cti)
#pragma unroll
        for (int t = 0; t < 4; ++t)
#pragma unroll
          for (int j = 0; j < 4; ++j) rhs[cti][t][j] = bf2f(R[(t * 16 + fq * 4 + j) * 264 + (w * 2 + cti) * 16 + fr]);
      __builtin_amdgcn_sched_barrier(0);
      f32x4 Y[2][4];
      const f32x4 zf = f32x4{0.f, 0.f, 0.f, 0.f};
#pragma unroll
      for (int t = 0; t < 4; ++t) {
#pragma unroll
        for (int cti = 0; cti < 2; ++cti) {
          f32x4 acc = rhs[cti][t];
          if (t == 1) {
            acc = MFMA16(cat44(a10, z4), cat44(pack4(Y[cti][0]), z4), acc);
          } else if (t == 2) {
            acc = MFMA16(cat44(a20, a21), cat44(pack4(Y[cti][0]), pack4(Y[cti][1])), acc);
          } else if (t == 3) {
            acc = MFMA16(cat44(a30, a31), cat44(pack4(Y[cti][0]), pack4(Y[cti][1])), acc);
            acc = MFMA16(cat44(a32, z4), cat44(pack4(Y[cti][2]), z4), acc);
          }
          Y[cti][t] = MFMA16(cat44(ti[t], z4), cat44(pack4(acc), z4), zf);
        }
      }
#pragma unroll
      for (int cti = 0; cti < 2; ++cti)
#pragma unroll
        for (int t = 0; t < 4; ++t)
#pragma unroll
          for (int j = 0; j < 4; ++j) R[(t * 16 + fq * 4 + j) * 264 + (w * 2 + cti) * 16 + fr] = f2bf(Y[cti][t][j]);
    }
    __syncthreads();
    if (DNSEL & 16) {
      LANE_VARS
      bf16x8 Bs[4];
#pragma unroll
      for (int kk = 0; kk < 4; ++kk) Bs[kk] = cat44(pack4(S[2 * kk]), pack4(S[2 * kk + 1]));
      f32x4 vnew[4], qS[4];
#pragma unroll
      for (int tt = 0; tt < 4; ++tt) {
        f32x4 aw = f32x4{0.f, 0.f, 0.f, 0.f}, aq = f32x4{0.f, 0.f, 0.f, 0.f};
#pragma unroll
        for (int kk = 0; kk < 4; ++kk) {
          const u16* wp = R + (tt * 16 + fr) * 264 + 128 + kk * 32 + fq * 4;
          const u16* qp = qsc + (tt * 16 + fr) * 136 + kk * 32 + fq * 4;
          bf16x8 Aw = cat44(*(const bf16x4*)wp, *(const bf16x4*)(wp + 16));
          bf16x8 Aq = cat44(*(const bf16x4*)qp, *(const bf16x4*)(qp + 16));
          aw = MFMA16(Aw, Bs[kk], aw);
          aq = MFMA16(Aq, Bs[kk], aq);
        }
#pragma unroll
        for (int j = 0; j < 4; ++j) vnew[tt][j] = bf2f(R[(tt * 16 + fq * 4 + j) * 264 + w * 16 + fr]) - aw[j];
        qS[tt] = aq;
      }
      bf16x8 Bv[2];
      Bv[0] = cat44(pack4(vnew[0]), pack4(vnew[1]));
      Bv[1] = cat44(pack4(vnew[2]), pack4(vnew[3]));
      const float dl = __expf(gcc[63]);
#pragma unroll
      for (int tt = 0; tt < 4; ++tt) {
        f32x4 o2 = f32x4{0.f, 0.f, 0.f, 0.f};
#pragma unroll
        for (int k2 = 0; k2 < 2; ++k2) {
          const u16* ap = qkm + (tt * 16 + fr) * 72 + k2 * 32 + fq * 4;
          bf16x8 Aqk = cat44(*(const bf16x4*)ap, *(const bf16x4*)(ap + 16));
          o2 = MFMA16(Aqk, Bv[k2], o2);
        }
#pragma unroll
        for (int j = 0; j < 4; ++j) {
          const int ip = tt * 16 + fq * 4 + j;
          const int inat = dir ? 63 - ip : ip;
          const float o = __expf(gcc[ip]) * qS[tt][j] + o2[j];
          obuf[((size_t)tokbase + cn * 64 + inat) * 1024 + h * 128 + w * 16 + fr] = o;
        }
      }
#pragma unroll
      for (int dt = 0; dt < 8; ++dt) {
        f32x4 sn;
        sn[0] = S[dt][0] * dl; sn[1] = S[dt][1] * dl; sn[2] = S[dt][2] * dl; sn[3] = S[dt][3] * dl;
#pragma unroll
        for (int k2 = 0; k2 < 2; ++k2) {
          const u16* ap = kdc + (dt * 16 + fr) * 72;
          bf16x8 Ak = cat44(*(const bf16x4*)(ap + ((k2 * 32 + fq * 4) ^ (dt << 3))), *(const bf16x4*)(ap + ((k2 * 32 + 16 + fq * 4) ^ (dt << 3))));
          sn = MFMA16(Ak, Bv[k2], sn);
        }
        S[dt] = sn;
      }
      if (s + 1 < nch) DN_A1(qsn, kdn, gcn, btn);
    }
    __syncthreads();
  }
  if (!sample) {
    float* so = p.out + (dir ? OUT_SB : OUT_SF) + (size_t)(seq * 8 + h) * 16384;
#pragma unroll
    for (int dt = 0; dt < 8; ++dt)
#pragma unroll
      for (int j = 0; j < 4; ++j) so[(dt * 16 + fq * 4 + j) * 128 + w * 16 + fr] = S[dt][j];
  }
}

#undef DN_A1
#undef DN_A2
DI void phase3(const Params& p, char* shm) {
  const int lane = threadIdx.x & 63;
  float a = p.lq1[lane] * p.lk1[lane], b = p.lq2[lane] * p.lk2[lane];
#pragma unroll
  for (int o = 32; o > 0; o >>= 1) { a += __shfl_xor(a, o); b += __shfl_xor(b, o); }
  const float lam = __expf(a) - __expf(b) + 0.2f;
  bool did_long = false;
  int* ctr = (int*)(p.ws + OFF_MISC);
  volatile int* s_item = (volatile int*)(shm + 163712);
#pragma unroll 1
  for (;;) {
    __syncthreads();
    if (threadIdx.x == 0) *s_item = atomicAdd(ctr, 1);
    __syncthreads();
    const int item = *s_item;
    if (item >= 832) break;
    int isdn, arg;
    if (item < 64) { isdn = 1; arg = ((16 + (item >> 4)) << 4) | (item & 15); }
    else if (item < 320) { isdn = 0; arg = item - 64; }
    else if (item < 576) { isdn = 1; arg = item - 320; }
    else { isdn = 0; arg = item - 576 + 256; }
    if (isdn) dn_item(p, arg >> 4, (arg >> 1) & 7, arg & 1, shm);
    else attn_item(p, arg, shm, lam);
    if (item < 64) did_long = true;
    __syncthreads();
  }
  if (!did_long) transposes_dyn(p, shm, (int*)(p.ws + OFF_MISC + 128), 592, 1648, 1648, 2);
}

DI void phase4(const Params& p) {
  const int tid = threadIdx.x, lane = tid & 63, w = tid >> 6;
  const float* of = (const float*)(p.ws + OFF_OF);
  const float* ob = (const float*)(p.ws + OFF_OB);
  const u16* Z = (const u16*)(p.ws + OFF_Z);
  u16* obuf = (u16*)(p.ws + OFF_ABUF);
  const int dv4 = (lane & 31) * 4;
  const float4 g = *(const float4*)(p.dn_norm_g + dv4);
  for (int it = blockIdx.x; it < 4096; it += gridDim.x) {
    const int pi = it * 16 + w * 2 + (lane >> 5);
    const int tok = pi >> 3, h = pi & 7;
    const size_t off = (size_t)tok * 1024 + h * 128 + dv4;
    float4 a = *(const float4*)(of + off), b = *(const float4*)(ob + off);
    a.x += b.x; a.y += b.y; a.z += b.z; a.w += b.w;
    float ss = a.x * a.x + a.y * a.y + a.z * a.z + a.w * a.w;
#pragma unroll
    for (int o = 1; o < 32; o <<= 1) ss += __shfl_xor(ss, o);
    const float rs = rsqrtf(ss * (1.f / 128.f) + 1e-6f);
    bf16x4 dg = *(const bf16x4*)(Z + (size_t)tok * NINP + 6144 + h * 128 + dv4);
    f32x4 o;
    o[0] = a.x * rs * g.x * silu_f(bf2f(dg[0]));
    o[1] = a.y * rs * g.y * silu_f(bf2f(dg[1]));
    o[2] = a.z * rs * g.z * silu_f(bf2f(dg[2]));
    o[3] = a.w * rs * g.w * silu_f(bf2f(dg[3]));
    *(bf16x4*)(obuf + (size_t)tok * DM + 1024 + h * 128 + dv4) = pack4(o);
  }
}

DI void phase8(const Params& p) {
  const u16* UB = (const u16*)(p.ws + OFF_UB);
  u16* act = (u16*)(p.ws + OFF_ACT);
  const bf16x8 zero8 = {0, 0, 0, 0, 0, 0, 0, 0};
#pragma unroll 1
  for (int task = blockIdx.x * NTHR + threadIdx.x; task < 256 * 704; task += gridDim.x * NTHR) {
    const int ridx = task / 704, ch = (task % 704) * 8;
    const int blk = ridx >> 1, last = ridx & 1;
    const int r = blk * 64 + (last ? 63 : 0);
    const int pn = ch >> 7, c = ch & 127;
    const int s0 = blk * 4 + (last ? 3 : 0);
    const int sm = last ? blk * 4 + 2 : (blk - 1) * 4 + 3;
    const int sp = last ? (blk + 1) * 4 + 0 : blk * 4 + 1;
    const bool okm = last ? true : ((r < NPR) ? ((r & 255) != 0) : (((r - NPR) & 1023) != 0));
    const bool okp = last ? (((r + 1) < NPR) ? (((r + 1) & 255) != 0) : ((((r + 1) - NPR) & 1023) != 0)) : true;
    const size_t co = (size_t)pn * 256 + c;
    bf16x8 gm = zero8, vm = zero8, gp = zero8, vp = zero8;
    const bf16x8 g0 = *(const bf16x8*)(UB + (size_t)s0 * NUP + co), v0 = *(const bf16x8*)(UB + (size_t)s0 * NUP + co + 128);
    if (okm) { gm = *(const bf16x8*)(UB + (size_t)sm * NUP + co); vm = *(const bf16x8*)(UB + (size_t)sm * NUP + co + 128); }
    if (okp) { gp = *(const bf16x8*)(UB + (size_t)sp * NUP + co); vp = *(const bf16x8*)(UB + (size_t)sp * NUP + co + 128); }
    bf16x8 o;
#pragma unroll
    for (int e = 0; e < 8; ++e) {
      const float gg = p.conv_ffn_w[ch + e] * bf2f(gm[e]) + p.conv_ffn_w[NUP + ch + e] * bf2f(g0[e]) + p.conv_ffn_w[2 * NUP + ch + e] * bf2f(gp[e]);
      const float vv = p.conv_ffn_w[DFF + ch + e] * bf2f(vm[e]) + p.conv_ffn_w[NUP + DFF + ch + e] * bf2f(v0[e]) +
                       p.conv_ffn_w[2 * NUP + DFF + ch + e] * bf2f(vp[e]);
      o[e] = (short)f2bf(silu_f(gg) * vv);
    }
    *(bf16x8*)(act + (size_t)r * DFF + ch) = o;
  }
}

#define XB_TMO      128
#define XB_XCNT(j)  (256  + 64 * (j))
#define XB_XSUB(j)  (1280 + 64 * (j))
#define XB_XGEN(j)  (2304 + 64 * (j))
#define XB_TOP      3328
#define XB_TOPGEN   3392
#define XCD_BAR_WORDS 3456
#define XB_SPIN_CAP (1u << 18)
#define LAS __attribute__((address_space(3)))
DI unsigned xb_ld(unsigned* p) { return __hip_atomic_load(p, __ATOMIC_RELAXED, __HIP_MEMORY_SCOPE_AGENT); }
DI unsigned xb_add(unsigned* p, unsigned v) { return __hip_atomic_fetch_add(p, v, __ATOMIC_RELAXED, __HIP_MEMORY_SCOPE_AGENT); }
DI unsigned xb_xcc_id() { return (unsigned)__builtin_amdgcn_s_getreg((3 << 11) | 20) & 0xFu; }
#define XB_SPIN(cond, bar) do { unsigned _sp = 0; while (cond) { __builtin_amdgcn_s_sleep(1); \
    if ((++_sp & 255u) == 0u) { if (xb_ld(&(bar)[XB_TMO])) break; if (_sp > XB_SPIN_CAP) { atomicAdd(&(bar)[XB_TMO], 1u); break; } } } } while (0)
struct XcdBarrier { unsigned* bar; unsigned x; volatile LAS unsigned* st; };
DI XcdBarrier xcd_barrier_post(unsigned* bar, volatile LAS unsigned* st) {
  XcdBarrier b; b.bar = bar; b.x = xb_xcc_id(); b.st = st;
  if (threadIdx.x == 0) (void)xb_add(&bar[XB_XCNT(b.x)], 1u);
  return b;
}
DI void xcd_barrier_complete(unsigned* bar, unsigned x, unsigned& nloc, unsigned& nx) {
  const unsigned G = gridDim.x * gridDim.y * gridDim.z;
  unsigned sum, cnt, mine, sp = 0u;
  for (;;) {
    sum = 0u; cnt = 0u; mine = 0u;
#pragma unroll
    for (unsigned j = 0; j < 16; ++j) { const unsigned c = xb_ld(&bar[XB_XCNT(j)]); sum += c; cnt += (c > 0u) ? 1u : 0u; mine = (j == x) ? c : mine; }
    if (sum == G) break;
    __builtin_amdgcn_s_sleep(1);
    if ((++sp & 255u) == 0u) { if (xb_ld(&bar[XB_TMO])) break; if (sp > XB_SPIN_CAP) { atomicAdd(&bar[XB_TMO], 1u); break; } }
  }
  nloc = mine > 0u ? mine : 1u; nx = cnt > 0u ? cnt : 1u;
}
DI void xcd_barrier(const XcdBarrier& b) {
  asm volatile("s_waitcnt vmcnt(0)" ::: "memory");
  __syncthreads();
  if (threadIdx.x == 0) {
    unsigned* bar = b.bar;
    __builtin_amdgcn_s_waitcnt(0);
    unsigned nloc = b.st[0], nx = b.st[1];
    if (nloc == 0u) { xcd_barrier_complete(bar, b.x, nloc, nx); b.st[0] = nloc; b.st[1] = nx; }
    const unsigned old = xb_add(&bar[XB_XSUB(b.x)], 1u);
    const unsigned gen = old / nloc;
    if (old + 1u == (gen + 1u) * nloc) {
      __builtin_amdgcn_fence(__ATOMIC_RELEASE, "agent");
      asm volatile("s_waitcnt vmcnt(0)" ::: "memory");
      const unsigned og = xb_add(&bar[XB_TOP], 1u);
      const unsigned tg = og / nx;
      if (og + 1u == (tg + 1u) * nx) xb_add(&bar[XB_TOPGEN], 1u);
      else XB_SPIN(xb_ld(&bar[XB_TOPGEN]) == tg, bar);
      __builtin_amdgcn_fence(__ATOMIC_ACQUIRE, "agent");
      xb_add(&bar[XB_XGEN(b.x)], 1u);
      asm volatile("s_waitcnt vmcnt(0)" ::: "memory");
    } else {
      XB_SPIN(xb_ld(&bar[XB_XGEN(b.x)]) == gen, bar);
      __builtin_amdgcn_fence(__ATOMIC_ACQUIRE, "agent");
      asm volatile("s_waitcnt vmcnt(0)" ::: "memory");
    }
  }
  __syncthreads();
}

__global__ void __launch_bounds__(NTHR) mega(Params p) {
  cg::grid_group grid = cg::this_grid();
  char* shm = g_shm;
  __shared__ uint4 xb_words;
  if (threadIdx.x == 0) xb_words = make_uint4(0u, 0u, 0u, 0u);
  __syncthreads();
  XcdBarrier xb = xcd_barrier_post((unsigned*)(p.ws + OFF_BAR), (volatile LAS unsigned*)&xb_words);
  if (p.phase_hi > 1000) grid.sync();
#ifndef ONLY
#define ONLY -1
#endif
#ifndef DOUBLE_PHASE
#define DOUBLE_PHASE -1
#endif
#define RUN(ph, call)                                                   \
  if (p.phase_lo <= (ph) && (ph) < p.phase_hi) {                        \
    if ((ph) > p.phase_lo) xcd_barrier(xb);                             \
    if (ONLY < 0 || ONLY == (ph)) { call; }                             \
    if (DOUBLE_PHASE == (ph)) { xcd_barrier(xb); if (blockIdx.x == 0 && threadIdx.x == 0) *(int*)(p.ws + OFF_MISC) = 0; xcd_barrier(xb); call; } \
  }
  RUN(0, phase0(p, shm))
  RUN(1, norm_mod_phase<0>(p, shm))
  RUN(2, gemm_phase<1>(p, (const u16*)(p.ws + OFF_ABUF), (const u16*)(p.ws + OFF_WT_IN), NTOK, NINP, DM))
  RUN(11, dn_prep_phase(p, shm))
  RUN(3, phase3(p, shm))
  RUN(4, phase4(p))
  RUN(5, gemm_phase<2>(p, (const u16*)(p.ws + OFF_ABUF), (const u16*)(p.ws + OFF_WT_OUT), NTOK, DM, DM))
  RUN(6, (norm_mod_phase<1>(p, shm), transposes_dyn(p, shm, (int*)(p.ws + OFF_MISC + 128), 592, 1296, 1648, 1 << 30)))
  RUN(7, gemm_phase<3>(p, (const u16*)(p.ws + OFF_ABUF), (const u16*)(p.ws + OFF_WT_UP), NTOK, NUP, DM))
  RUN(8, (phase8(p), transposes_dyn(p, shm, (int*)(p.ws + OFF_MISC + 128), 592, 1648, 1648, 1 << 30)))
  RUN(9, gemm_phase<4>(p, (const u16*)(p.ws + OFF_ACT), (const u16*)(p.ws + OFF_WT_DOWN), NTOK, DM, DFF))
  RUN(10, final_norm_phase(p))
}

#ifndef N_LAUNCH_SPLIT
#define N_LAUNCH_SPLIT 0
#endif

extern "C" void kernel_launch(void* const* d_in, const int* in_sizes, int n_in, void* d_out, int out_size, void* d_ws,
                              size_t ws_size, hipStream_t stream) {
  static int grid_blocks = 0;
  if (!grid_blocks) {
    int dev = 0, cus = 0, per_cu = 0;
    hipGetDevice(&dev);
    hipDeviceGetAttribute(&cus, hipDeviceAttributeMultiprocessorCount, dev);
    hipFuncSetAttribute((const void*)mega, hipFuncAttributeMaxDynamicSharedMemorySize, LDS_BYTES);
    hipOccupancyMaxActiveBlocksPerMultiprocessor(&per_cu, mega, NTHR, LDS_BYTES);
    if (per_cu < 1) per_cu = 1;
    grid_blocks = cus * per_cu;
    if (grid_blocks > 256) grid_blocks = 256;
  }
  Params p{};
  const float** f = (const float**)&p;
  for (int i = 0; i < 27; ++i) f[i] = (const float*)d_in[i];
  p.out = (float*)d_out;
  p.ws = (char*)d_ws;
#if N_LAUNCH_SPLIT
  for (int ph = 0; ph < 11; ++ph) {
    p.phase_lo = ph; p.phase_hi = ph + 1;
    hipLaunchKernelGGL(mega, dim3(grid_blocks), dim3(NTHR), LDS_BYTES, stream, p);
  }
#else
  p.phase_lo = 0; p.phase_hi = 12;
  hipMemsetAsync((char*)d_ws + OFF_MISC, 0, 256 + 3456 * 4, stream);
  void* args[] = {&p};
  hipError_t e = hipLaunchCooperativeKernel((void*)mega, dim3(grid_blocks), dim3(NTHR), args, LDS_BYTES, stream);
  if (e != hipSuccess) fprintf(stderr, "cooperative launch failed: %s (grid %d)\n", hipGetErrorString(e), grid_blocks);
#endif
}
```
